# Optimizing an MI355X kernel written in HIP

```python
import jax
import jax.numpy as jnp
from jax import lax
import numpy as np

D_MODEL = 1024
BATCH = 16
SEQ = 4096
DEPTH = 2

CTX_LEN = 256
GRID_W = 64
NORM_EPS = 1e-6
ROPE_BASE = 10000.0
NEG_INF = -1e30
F32 = jnp.float32

M_HEADS = 4
M_HEAD_DIM = 128
M_WIDTH = M_HEADS * M_HEAD_DIM
M_CONV = 3
M_CHUNK = 64
M_FORGET_BIAS_LO = 3.0
M_FORGET_BIAS_HI = 6.0

A_HEADS = 8
A_KV_HEADS = 2
A_GROUP = A_HEADS // A_KV_HEADS
A_HEAD_DIM = 64
A_WIDTH = A_HEADS * A_HEAD_DIM
A_KV_WIDTH = A_KV_HEADS * A_HEAD_DIM
A_WINDOW = 128
A_BLOCK = 128

R_HEADS = 4
R_QK_DIM = 128
R_V_DIM = 256
R_QK_WIDTH = R_HEADS * R_QK_DIM
R_V_WIDTH = R_HEADS * R_V_DIM
R_CHUNK = 128

FFN_DIM = 2816
FFN_CONV = 3

IN_SPLITS = (M_WIDTH, M_WIDTH, M_WIDTH, M_WIDTH, 4 * M_HEADS,
             A_WIDTH, A_KV_WIDTH, A_KV_WIDTH,
             R_QK_WIDTH, R_QK_WIDTH, R_V_WIDTH, R_V_WIDTH,
             D_MODEL, D_MODEL, D_MODEL)
IN_COLS = sum(IN_SPLITS)

kernel_name = 'hybrid_mlstm_swa_retention_dit_block'


def _split_cols(w):
    offs = []
    acc = 0
    for s in IN_SPLITS[:-1]:
        acc += s
        offs.append(acc)
    return jnp.split(w, offs, axis=-1)


def _rmsnorm(x, w):
    xf = x.astype(F32)
    y = xf * lax.rsqrt(jnp.mean(xf * xf, axis=-1, keepdims=True) + NORM_EPS)
    return (y * w.astype(F32)).astype(x.dtype)


def _head_norm(y, w, n_heads, dt):
    shp = y.shape
    yf = y.astype(F32).reshape(shp[:-1] + (n_heads, shp[-1] // n_heads))
    mu = jnp.mean(yf, axis=-1, keepdims=True)
    var = jnp.mean(jnp.square(yf - mu), axis=-1, keepdims=True)
    yf = ((yf - mu) * lax.rsqrt(var + NORM_EPS)).reshape(shp)
    return (yf * w.astype(F32)).astype(dt)


def _modulation(cvec, w, b, n):
    return jnp.split(jax.nn.silu(cvec) @ w + b, n, axis=-1)


def _dwconv(x, w):
    K = w.shape[0]
    T = x.shape[1]
    r = K // 2
    xp = jnp.pad(x, ((0, 0), (r, r), (0, 0)))
    out = xp[:, 0:T] * w[0]
    for j in range(1, K):
        out = out + xp[:, j:j + T] * w[j]
    return out


def _rope_rotate(x, pos):
    half = x.shape[-1] // 2
    inv = ROPE_BASE ** (-jnp.arange(half, dtype=F32) / half)
    ang = pos.astype(F32)[:, None] * inv[None, :]
    cos = jnp.cos(ang)[None, :, None, :]
    sin = jnp.sin(ang)[None, :, None, :]
    xf = x.astype(F32)
    x1, x2 = xf[..., :half], xf[..., half:]
    return jnp.concatenate([x1 * cos - x2 * sin, x1 * sin + x2 * cos], axis=-1).astype(x.dtype)


def _axial_rope(x, row, col):
    half = x.shape[-1] // 2
    return jnp.concatenate([_rope_rotate(x[..., :half], row), _rope_rotate(x[..., half:], col)], axis=-1)


def _to_heads(t, n_heads):
    B, T, W = t.shape
    return t.reshape(B, T, n_heads, W // n_heads).transpose(0, 2, 1, 3)


def _from_heads(t):
    B, H, T, d = t.shape
    return t.transpose(0, 2, 1, 3).reshape(B, T, H * d)


def _flip(t):
    return jnp.flip(t, axis=2)


def _flip_opt(t):
    return None if t is None else _flip(t)


def _window_attention(q, k, v, kc, vc, sink):
    B, S, Hkv, G, hd = q.shape
    L = kc.shape[1]
    nb = S // A_BLOCK
    span = 3 * A_BLOCK
    scale = hd ** -0.5
    pad = ((0, 0), (A_BLOCK, A_BLOCK), (0, 0), (0, 0))
    kp = jnp.pad(k, pad).reshape(B, nb + 2, A_BLOCK, Hkv, hd)
    vp = jnp.pad(v, pad).reshape(B, nb + 2, A_BLOCK, Hkv, hd)
    kw = jnp.concatenate([kp[:, :nb], kp[:, 1:nb + 1], kp[:, 2:]], axis=2)
    vw = jnp.concatenate([vp[:, :nb], vp[:, 1:nb + 1], vp[:, 2:]], axis=2)
    qb = q.reshape(B, nb, A_BLOCK, Hkv, G, hd)
    blk = jnp.arange(nb)[:, None, None]
    qi = blk * A_BLOCK + jnp.arange(A_BLOCK)[None, :, None]
    kj = (blk - 1) * A_BLOCK + jnp.arange(span)[None, None, :]
    mask = (jnp.abs(qi - kj) <= A_WINDOW) & (kj >= 0) & (kj < S)
    sink_col = jnp.broadcast_to(sink[None, :, :, None, None], (B, Hkv, G, A_BLOCK, 1))

    def block(args):
        qx, kx, vx, mx = args
        s_loc = jnp.einsum('bqhgd,bkhd->bhgqk', qx, kx).astype(F32) * scale
        s_loc = jnp.where(mx[None, None, None], s_loc, NEG_INF)
        s_ctx = jnp.einsum('bqhgd,bchd->bhgqc', qx, kc).astype(F32) * scale
        p = jax.nn.softmax(jnp.concatenate([s_loc, s_ctx, sink_col], axis=-1), axis=-1).astype(vx.dtype)
        return (jnp.einsum('bhgqk,bkhd->bqhgd', p[..., :span], vx)
                + jnp.einsum('bhgqc,bchd->bqhgd', p[..., span:span + L], vc))

    out = lax.map(block, (jnp.moveaxis(qb, 1, 0), jnp.moveaxis(kw, 1, 0), jnp.moveaxis(vw, 1, 0), mask))
    return jnp.moveaxis(out, 0, 1).reshape(B, S, Hkv * G * hd)


def _context_attention(qc, kc, vc, sink):
    B, L, Hkv, G, hd = qc.shape
    s = jnp.einsum('bqhgd,bkhd->bhgqk', qc, kc).astype(F32) * (hd ** -0.5)
    sink_col = jnp.broadcast_to(sink[None, :, :, None, None], (B, Hkv, G, L, 1))
    p = jax.nn.softmax(jnp.concatenate([s, sink_col], axis=-1), axis=-1)[..., :L].astype(vc.dtype)
    return jnp.einsum('bhgqk,bkhd->bqhgd', p, vc).reshape(B, L, Hkv * G * hd)


def _mlstm_states(k, v, log_i, log_f, state0):
    B, H, T, dk = k.shape
    dv = v.shape[-1]
    N = T // M_CHUNK
    kc = k.reshape(B, H, N, M_CHUNK, dk)
    vc = v.reshape(B, H, N, M_CHUNK, dv)
    b = jnp.cumsum(log_f.reshape(B, H, N, M_CHUNK), axis=-1)
    g = b[..., -1]
    a = g[..., None] - b + log_i.reshape(B, H, N, M_CHUNK)

    def step(carry, xs):
        C, n, m = carry
        kx, vx, ax, gx = xs
        m_new = jnp.maximum(gx + m, jnp.max(ax, axis=-1))
        w = jnp.exp(ax - m_new[..., None])
        decay = jnp.exp(gx + m - m_new)
        C_new = decay[..., None, None] * C + jnp.einsum('bhlv,bhlk->bhvk', vx * w[..., None], kx)
        n_new = decay[..., None] * n + jnp.einsum('bhl,bhlk->bhk', w, kx)
        return (C_new, n_new, m_new), (C, n, m)

    xs = (jnp.moveaxis(kc, 2, 0), jnp.moveaxis(vc, 2, 0), jnp.moveaxis(a, 2, 0), jnp.moveaxis(g, 2, 0))
    final, starts = lax.scan(step, state0, xs)
    return starts, final, b


def _mlstm_outputs(q, k, v, log_i, b, starts):
    B, H, T, dk = q.shape
    dv = v.shape[-1]
    N = T // M_CHUNK
    C, n, m = [jnp.moveaxis(s_, 0, 2) for s_ in starts]
    qc = q.reshape(B, H, N, M_CHUNK, dk)
    kc = k.reshape(B, H, N, M_CHUNK, dk)
    vc = v.reshape(B, H, N, M_CHUNK, dv)
    ic = log_i.reshape(B, H, N, M_CHUNK)
    lower = jnp.tril(jnp.ones((M_CHUNK, M_CHUNK), dtype=bool))
    d_log = jnp.where(lower, b[..., :, None] - b[..., None, :] + ic[..., None, :], -jnp.inf)
    inter_log = b + m[..., None]
    m_j = jnp.maximum(inter_log, jnp.max(d_log, axis=-1))
    inter_w = jnp.exp(inter_log - m_j)
    s = jnp.einsum('bhnjd,bhnrd->bhnjr', qc, kc) * jnp.exp(d_log - m_j[..., None])
    num = (inter_w[..., None] * jnp.einsum('bhnvk,bhnjk->bhnjv', C, qc)
           + jnp.einsum('bhnjr,bhnrv->bhnjv', s, vc))
    den = inter_w * jnp.einsum('bhnk,bhnjk->bhnj', n, qc) + jnp.sum(s, axis=-1)
    h = num / jnp.maximum(jnp.abs(den), jnp.exp(-m_j))[..., None]
    return h.reshape(B, H, T, dv)


def _mlstm_dir(qc, kc, vc, ic, fc, qx, kx, vx, ix, fx):
    B, H, _, dk = kx.shape
    dv = vx.shape[-1]
    zero = (jnp.zeros((B, H, dv, dk), F32), jnp.zeros((B, H, dk), F32), jnp.zeros((B, H), F32))
    st_c, fin_c, b_c = _mlstm_states(kc, vc, ic, fc, zero)
    st_x, _, b_x = _mlstm_states(kx, vx, ix, fx, fin_c)
    hx = _mlstm_outputs(qx, kx, vx, ix, b_x, st_x)
    hc = None if qc is None else _mlstm_outputs(qc, kc, vc, ic, b_c, st_c)
    return hx, hc


def _mlstm_bidir(qc, kc, vc, gc, qx, kx, vx, gx):
    icf, fcf, icb, fcb = gc
    ixf, fxf, ixb, fxb = gx
    hx_f, hc_f = _mlstm_dir(qc, kc, vc, icf, fcf, qx, kx, vx, ixf, fxf)
    hx_b, hc_b = _mlstm_dir(_flip_opt(qc), _flip(kc), _flip(vc), _flip(icb), _flip(fcb),
                            _flip(qx), _flip(kx), _flip(vx), _flip(ixb), _flip(fxb))
    hx = _from_heads(hx_f + _flip(hx_b))
    hc = None if qc is None else _from_heads(hc_f + _flip(hc_b))
    return hx, hc


def _ret_states(k, v, log_g, state0):
    B, H, T, dk = k.shape
    dv = v.shape[-1]
    N = T // R_CHUNK
    kc = k.reshape(B, H, N, R_CHUNK, dk)
    vc = v.reshape(B, H, N, R_CHUNK, dv)
    pos = jnp.arange(R_CHUNK, dtype=F32)
    w = jnp.exp(log_g[:, None] * (R_CHUNK - 1.0 - pos)[None, :])
    chunk_decay = jnp.exp(log_g * R_CHUNK)

    def step(R, xs):
        kx, vx = xs
        R_new = (chunk_decay[None, :, None, None] * R
                 + jnp.einsum('bhlk,bhlv->bhkv', kx * w[None, :, :, None], vx))
        return R_new, R

    final, starts = lax.scan(step, state0, (jnp.moveaxis(kc, 2, 0), jnp.moveaxis(vc, 2, 0)))
    return starts, final


def _ret_outputs(q, k, v, log_g, starts):
    B, H, T, dk = q.shape
    dv = v.shape[-1]
    N = T // R_CHUNK
    qc = q.reshape(B, H, N, R_CHUNK, dk)
    kc = k.reshape(B, H, N, R_CHUNK, dk)
    vc = v.reshape(B, H, N, R_CHUNK, dv)
    R = jnp.moveaxis(starts, 0, 2)
    pos = jnp.arange(R_CHUNK, dtype=F32)
    diff = pos[:, None] - pos[None, :]
    decay = jnp.where(diff >= 0, jnp.exp(log_g[:, None, None] * jnp.maximum(diff, 0.0)), 0.0)
    s = jnp.einsum('bhnjd,bhnrd->bhnjr', qc, kc) * decay[None, :, None]
    inter = jnp.exp(log_g[:, None] * (pos + 1.0)[None, :])
    out = (jnp.einsum('bhnjr,bhnrv->bhnjv', s, vc)
           + inter[None, :, None, :, None] * jnp.einsum('bhnjk,bhnkv->bhnjv', qc, R))
    return out.reshape(B, H, T, dv)


def _ret_dir(qc, kc, vc, qx, kx, vx, log_g):
    B, H, _, dk = kx.shape
    dv = vx.shape[-1]
    st_c, fin_c = _ret_states(kc, vc, log_g, jnp.zeros((B, H, dk, dv), F32))
    st_x, _ = _ret_states(kx, vx, log_g, fin_c)
    hx = _ret_outputs(qx, kx, vx, log_g, st_x)
    hc = None if qc is None else _ret_outputs(qc, kc, vc, log_g, st_c)
    return hx, hc


def _ret_bidir(qc, kc, vc, qx, kx, vx, log_g):
    hx_f, hc_f = _ret_dir(qc, kc, vc, qx, kx, vx, log_g[0])
    hx_b, hc_b = _ret_dir(_flip_opt(qc), _flip(kc), _flip(vc), _flip(qx), _flip(kx), _flip(vx), log_g[1])
    hx = _from_heads(hx_f + _flip(hx_b))
    hc = None if qc is None else _from_heads(hc_f + _flip(hc_b))
    return hx, hc


def _token_mixer(h, hc, row, col, w_in, m_gate_bias, m_conv_w, m_norm_w, a_sink, ret_logit, ret_norm_w,
                 w_br_m, w_br_a, w_br_r, w_out, need_ctx):
    dt = h.dtype
    B, S, _ = h.shape
    L = hc.shape[1]
    (w_mq, w_mk, w_mv, w_mo, w_mg, w_aq, w_ak, w_av,
     w_rq, w_rk, w_rv, w_rg, w_gm, w_ga, w_gr) = _split_cols(w_in)
    conv_q, conv_k = m_conv_w[:, :M_WIDTH], m_conv_w[:, M_WIDTH:]

    def m_q(t):
        return _to_heads(jax.nn.silu(_dwconv(t @ w_mq, conv_q)), M_HEADS).astype(F32)

    def m_k(t):
        return _to_heads(jax.nn.silu(_dwconv(t @ w_mk, conv_k)), M_HEADS).astype(F32) * (M_HEAD_DIM ** -0.5)

    def m_v(t):
        return _to_heads(t @ w_mv, M_HEADS).astype(F32)

    def m_gates(t):
        Bt, Tt, _ = t.shape
        g = (t @ w_mg + m_gate_bias).astype(F32).reshape(Bt, Tt, 4, M_HEADS).transpose(2, 0, 3, 1)
        return (g[0], jax.nn.log_sigmoid(g[1]), g[2], jax.nn.log_sigmoid(g[3]))

    hm_x, hm_c = _mlstm_bidir(m_q(hc) if need_ctx else None, m_k(hc), m_v(hc), m_gates(hc),
                              m_q(h), m_k(h), m_v(h), m_gates(h))

    sink = a_sink.astype(F32).reshape(A_KV_HEADS, A_GROUP)
    q = _axial_rope((h @ w_aq).reshape(B, S, A_HEADS, A_HEAD_DIM), row, col)
    q = q.reshape(B, S, A_KV_HEADS, A_GROUP, A_HEAD_DIM)
    k = _axial_rope((h @ w_ak).reshape(B, S, A_KV_HEADS, A_HEAD_DIM), row, col)
    v = (h @ w_av).reshape(B, S, A_KV_HEADS, A_HEAD_DIM)
    kc = (hc @ w_ak).reshape(B, L, A_KV_HEADS, A_HEAD_DIM)
    vc = (hc @ w_av).reshape(B, L, A_KV_HEADS, A_HEAD_DIM)
    ya = _window_attention(q, k, v, kc, vc, sink)

    log_g = jax.nn.log_sigmoid(ret_logit.astype(F32))
    pos_c = jnp.arange(L)
    pos_x = L + jnp.arange(S)

    def r_qk(t, w, pos, scale):
        Bt, Tt, _ = t.shape
        r = _rope_rotate((t @ w).reshape(Bt, Tt, R_HEADS, R_QK_DIM), pos)
        return r.transpose(0, 2, 1, 3).astype(F32) * scale

    def r_v(t):
        return _to_heads(t @ w_rv, R_HEADS).astype(F32)

    k_scale = R_QK_DIM ** -0.5
    hr_x, hr_c = _ret_bidir(r_qk(hc, w_rq, pos_c, 1.0) if need_ctx else None, r_qk(hc, w_rk, pos_c, k_scale),
                            r_v(hc), r_qk(h, w_rq, pos_x, 1.0), r_qk(h, w_rk, pos_x, k_scale), r_v(h), log_g)

    def mlstm_out(t, hm):
        return jax.nn.sigmoid(t @ w_mo) * _head_norm(hm, m_norm_w, M_HEADS, dt)

    def ret_out(t, hr):
        return jax.nn.silu(t @ w_rg) * _head_norm(hr, ret_norm_w, R_HEADS, dt)

    def merge(t, ym_, ya_, yr_):
        return (jax.nn.sigmoid(t @ w_gm) * (ym_ @ w_br_m)
                + jax.nn.sigmoid(t @ w_ga) * (ya_ @ w_br_a)
                + jax.nn.sigmoid(t @ w_gr) * (yr_ @ w_br_r)) @ w_out

    y = merge(h, mlstm_out(h, hm_x), ya, ret_out(h, hr_x))
    if need_ctx:
        qcx = (hc @ w_aq).reshape(B, L, A_KV_HEADS, A_GROUP, A_HEAD_DIM)
        ya_c = _context_attention(qcx, kc, vc, sink)
        yc = merge(hc, mlstm_out(hc, hm_c), ya_c, ret_out(hc, hr_c))
    else:
        yc = None
    return y, yc


def _conv_ffn(h, w_up, conv_w, conv_b, w_down):
    a, b = jnp.split(h @ w_up, 2, axis=-1)
    return (jax.nn.silu(_dwconv(a, conv_w) + conv_b) * b) @ w_down


def setup_inputs(seed: int = 0) -> dict:
    key = jax.random.key(seed)
    ks = jax.random.split(key, 24)
    D = D_MODEL

    def nrm(k, shape, scale):
        return jax.random.normal(k, shape, F32) * scale

    lin = jnp.linspace(M_FORGET_BIAS_LO, M_FORGET_BIAS_HI, M_HEADS, dtype=F32)
    zer = jnp.zeros((M_HEADS,), F32)
    gate_base = jnp.concatenate([zer, lin, zer, lin])
    ret_base = jnp.log(2.0 ** (5.0 + jnp.arange(R_HEADS, dtype=F32)) - 1.0)
    return {
        'x': nrm(ks[0], (BATCH, SEQ, D), 1.0),
        'c': nrm(ks[1], (BATCH, D), 1.0),
        'ctx': nrm(ks[2], (BATCH, CTX_LEN, D), 1.0),
        'c_ctx': nrm(ks[3], (D,), 1.0),
        'mod_w': nrm(ks[4], (DEPTH, D, 6 * D), 0.5 * D ** -0.5),
        'mod_b': nrm(ks[5], (DEPTH, 6 * D), 0.02),
        'norm1_w': 1.0 + nrm(ks[6], (DEPTH, D), 0.02),
        'norm2_w': 1.0 + nrm(ks[7], (DEPTH, D), 0.02),
        'w_in': nrm(ks[8], (DEPTH, D, IN_COLS), D ** -0.5),
        'm_gate_bias': gate_base[None, :] + nrm(ks[9], (DEPTH, 4 * M_HEADS), 0.1),
        'm_conv_w': nrm(ks[10], (DEPTH, M_CONV, 2 * M_WIDTH), M_CONV ** -0.5),
        'm_norm_w': 1.0 + nrm(ks[11], (DEPTH, M_WIDTH), 0.02),
        'a_sink': nrm(ks[12], (DEPTH, A_HEADS), 0.5),
        'ret_logit': ret_base[None, None, :] + nrm(ks[13], (DEPTH, 2, R_HEADS), 0.1),
        'ret_norm_w': 1.0 + nrm(ks[14], (DEPTH, R_V_WIDTH), 0.02),
        'w_br_m': nrm(ks[15], (DEPTH, M_WIDTH, D), M_WIDTH ** -0.5),
        'w_br_a': nrm(ks[16], (DEPTH, A_WIDTH, D), A_WIDTH ** -0.5),
        'w_br_r': nrm(ks[17], (DEPTH, R_V_WIDTH, D), R_V_WIDTH ** -0.5),
        'w_out': nrm(ks[18], (DEPTH, D, D), D ** -0.5),
        'ffn_up': nrm(ks[19], (DEPTH, D, 2 * FFN_DIM), D ** -0.5),
        'ffn_conv_w': nrm(ks[20], (DEPTH, FFN_CONV, FFN_DIM), FFN_CONV ** -0.5),
        'ffn_conv_b': nrm(ks[21], (DEPTH, FFN_DIM), 0.02),
        'ffn_down': nrm(ks[22], (DEPTH, FFN_DIM, D), FFN_DIM ** -0.5),
        'final_norm_w': 1.0 + nrm(ks[23], (D,), 0.02),
    }


def reference(x, c, ctx, c_ctx, mod_w, mod_b, norm1_w, norm2_w, w_in, m_gate_bias, m_conv_w, m_norm_w,
              a_sink, ret_logit, ret_norm_w, w_br_m, w_br_a, w_br_r, w_out, ffn_up, ffn_conv_w, ffn_conv_b,
              ffn_down, final_norm_w):
    S = x.shape[1]
    rows = S // GRID_W
    row = jnp.repeat(jnp.arange(rows), GRID_W)
    col = jnp.tile(jnp.arange(GRID_W), rows)
    cx = ctx
    for l in range(DEPTH):
        last = l == DEPTH - 1
        sh1, sc1, g1, sh2, sc2, g2 = [t[:, None, :] for t in _modulation(c, mod_w[l], mod_b[l], 6)]
        if last:
            csh1, csc1 = _modulation(c_ctx, mod_w[l][:, :2 * D_MODEL], mod_b[l][:2 * D_MODEL], 2)
        else:
            csh1, csc1, cg1, csh2, csc2, cg2 = _modulation(c_ctx, mod_w[l], mod_b[l], 6)
        h = _rmsnorm(x, norm1_w[l]) * (1.0 + sc1) + sh1
        hc = _rmsnorm(cx, norm1_w[l]) * (1.0 + csc1) + csh1
        y, yc = _token_mixer(h, hc, row, col, w_in[l], m_gate_bias[l], m_conv_w[l], m_norm_w[l], a_sink[l],
                             ret_logit[l], ret_norm_w[l], w_br_m[l], w_br_a[l], w_br_r[l], w_out[l],
                             not last)
        x = x + g1 * y
        h2 = _rmsnorm(x, norm2_w[l]) * (1.0 + sc2) + sh2
        x = x + g2 * _conv_ffn(h2, ffn_up[l], ffn_conv_w[l], ffn_conv_b[l], ffn_down[l])
        if not last:
            cx = cx + cg1 * yc
            hc2 = _rmsnorm(cx, norm2_w[l]) * (1.0 + csc2) + csh2
            cx = cx + cg2 * _conv_ffn(hc2, ffn_up[l], ffn_conv_w[l], ffn_conv_b[l], ffn_down[l])
    return _rmsnorm(x, final_norm_w)
```

```cpp
#include <hip/hip_runtime.h>
#include <hip/hip_cooperative_groups.h>
#include <cstdio>
#include <cstdint>
namespace cg = cooperative_groups;

#define DI __device__ __forceinline__
#define LAS __attribute__((address_space(3)))
#define GAS __attribute__((address_space(1)))
typedef unsigned short bf16_t;
typedef short bf16x8 __attribute__((ext_vector_type(8)));
typedef short s16x4 __attribute__((ext_vector_type(4)));
typedef float f32x4 __attribute__((ext_vector_type(4)));
typedef unsigned u32x4 __attribute__((ext_vector_type(4)));
typedef unsigned u32x2 __attribute__((ext_vector_type(2)));

constexpr int D = 1024, NBATCH = 16, SEQ = 4096, CTX = 256, PT = CTX + SEQ  ;
constexpr int HB = 8  , MH = HB * PT  , TPB = PT / 256  ;
constexpr int N_IN = 8960, FFN = 2816, IN_COLS = 8976;
constexpr size_t MiB = 1u << 20;
constexpr size_t WS_CTL = 0, WS_MOD = 1 * MiB, WS_TAB = 2 * MiB, WS_W = 5 * MiB, W_LAYER = 41 * MiB;
constexpr size_t WO_IN = 0, WO_BR = 18 * MiB, WO_OUT = 22 * MiB, WO_UP = 24 * MiB, WO_DN = 35 * MiB;
constexpr size_t WS_XC = 87 * MiB, WS_HN = 103 * MiB, WS_YCAT = 171 * MiB, WS_PROJ = 307 * MiB;
static_assert(WO_DN + (size_t)1024 * 2816 * 2 <= W_LAYER && WS_W + 2 * W_LAYER <= WS_XC, "weight map");
constexpr size_t SZ512 = (size_t)MH * 512 * 2;
constexpr size_t PO_MQ = WS_PROJ, PO_MK = PO_MQ + SZ512, PO_MV = PO_MK + SZ512, PO_MO = PO_MV + SZ512, PO_AQ = PO_MO + SZ512;
constexpr size_t PO_AK = PO_AQ + SZ512, PO_AV = PO_AK + SZ512 / 4, PO_RQ = PO_AV + SZ512 / 4, PO_RK = PO_RQ + SZ512, PO_RV = PO_RK + SZ512;
constexpr size_t PO_RG = PO_RV + 2 * SZ512, PO_G3 = PO_RG + 2 * SZ512, PO_MG = PO_G3 + 6 * SZ512, PO_END = PO_MG + (size_t)MH * 16 * 4;
constexpr size_t PO_MQC = PO_END, PO_MKC = PO_MQC + SZ512, WS_END = PO_MKC + SZ512;
static_assert(WS_END <= 1024 * MiB, "ws size");
constexpr size_t WS_HMB = WS_END, WS_HRB = PO_MQ, WS_END2 = WS_HMB + SZ512;
static_assert(WS_END2 <= 1024 * MiB && PO_MK == PO_MQ + SZ512, "ws size");
constexpr size_t WS_SQ = WS_HMB + SZ512;
static_assert(WS_SQ + (size_t)(MH / 64) * 4 * 1024 * 2 <= 1024 * MiB, "ws size");
constexpr size_t WS_FA = WS_PROJ, WS_FB = WS_FA + (size_t)MH * FFN * 2;
constexpr size_t WS_SA = WS_FA, WS_SB = WS_FA + 16 * MiB;
static_assert((size_t)(MH / 64) * 4 * FFN * 2 <= 16 * MiB && WS_SB + (size_t)(MH / 64) * 2 * FFN * 2 <= WS_FB, "side buffers");
static_assert(PO_END <= 1000 * MiB && WS_FB + (size_t)MH * FFN * 2 <= PO_G3, "ws map");
constexpr int TAB_COSR = 0, TAB_SINR = PT * 64, TAB_COSA = 2 * PT * 64, TAB_SINA = 2 * PT * 64 + 1024;

constexpr int LDS_BYTES = 147456;
#ifndef PH_MASK
#define PH_MASK 0xFFFF
#endif
#define PH(k) if constexpr ((PH_MASK >> (k)) & 1)
#ifndef DUP_MASK
#define DUP_MASK 0
#endif
#define NREP(k) (1 + ((DUP_MASK >> (k)) & 1))
#ifndef PROBE_SEL
#define PROBE_SEL 7
#endif

DI int lv(int x) { asm volatile("" : "+v"(x)); return x; }
DI int ls(int x) { asm volatile("" : "+s"(x)); return x; }
DI float ror1(float v) { return __builtin_bit_cast(float, __builtin_amdgcn_update_dpp(0, __builtin_bit_cast(int, v), 0x121, 0xF, 0xF, false)); }
DI float ror15(float v) { return __builtin_bit_cast(float, __builtin_amdgcn_update_dpp(0, __builtin_bit_cast(int, v), 0x12F, 0xF, 0xF, false)); }
DI unsigned cvt_pk_bf16(float lo, float hi) { unsigned r; asm volatile("v_cvt_pk_bf16_f32 %0, %1, %2" : "=v"(r) : "v"(lo), "v"(hi)); return r; }
DI float bf2f(unsigned short b) { return __uint_as_float(((unsigned)b) << 16); }
DI float bflo(unsigned w) { return __uint_as_float(w << 16); }
DI float bfhi(unsigned w) { return __uint_as_float(w & 0xffff0000u); }
DI float sigmoidf_(float x) { return __builtin_amdgcn_rcpf(1.f + __expf(-x)); }
DI float siluf_(float x) { return x * sigmoidf_(x); }
DI float logsigmoidf_(float x) { return fminf(x, 0.f) - __logf(1.f + __expf(-fabsf(x))); }
DI u32x2 pack4(f32x4 v) { u32x2 w; w.x = cvt_pk_bf16(v[0], v[1]); w.y = cvt_pk_bf16(v[2], v[3]); return w; }
DI f32x4 unpack4(u32x2 w) { return (f32x4){bflo(w.x), bfhi(w.x), bflo(w.y), bfhi(w.y)}; }

namespace pg8 {
constexpr int BM = 256, BK = 64, HALF = 128, HTB = HALF * BK * 2, STAGE_BYTES = 8 * HTB, NXCD = 8, WGM = 4;
__host__ __device__ __forceinline__ int lds_byte(int r, int c) { const int st = (r >> 4) * 2 + (c >> 5), rr = r & 15, cc = c & 31, ob = rr * 64 + cc * 2; return st * 1024 + (ob ^ (((ob >> 9) & 1) << 5)); }
__host__ __device__ __forceinline__ void stage_rc(int b, int& R, int& C) { const int st = b / 1024, sb = b % 1024, swz = sb ^ (((sb >> 9) & 1) << 5); R = (st >> 1) * 16 + swz / 64; C = (st & 1) * 32 + (swz % 64) / 2; }
__host__ __device__ __forceinline__ int perm32(int rho) { const int n = rho >> 4, i = rho & 15; return 8 * (i >> 2) + 4 * n + (i & 3); }
struct Unit { int pm, pn, br; };
struct StaticOrder {
    int nM, nN, nwg, G, c, lat;
    DI void init(int M, int N, int G_, int c_, int lat_ = 0) { lat = lat_; nM = lat_ ? HB * 16 : M / BM; nN = N / BM; nwg = nM * nN; G = G_; c = c_; }
    DI bool next(int i, Unit& u) const {
        const long L = (long)i * G + c; if (L >= nwg) return false;
        int wgid = (int)L; { const int q = nwg / NXCD, r = nwg % NXCD, xcd = wgid % NXCD, off = wgid / NXCD; wgid = (xcd < r ? xcd * (q + 1) : r * (q + 1) + (xcd - r) * q) + off; }
        const int nig = WGM * nN, gid = wgid / nig, fm = gid * WGM, gsz = (nM - fm) < WGM ? (nM - fm) : WGM;
        u.pm = fm + ((wgid % nig) % gsz); u.pn = (wgid % nig) / gsz; u.br = 0; if (lat) u.pm = (u.pm >> 4) * TPB + 1 + (u.pm & 15); return true;
    }
};
struct Sched1 {
    StaticOrder o; const char* A; const char* B; size_t tsA, tsB; int nt;
    DI bool next(int i, Unit& u) const { return o.next(i, u); }
    DI void locate(const Unit& u, const char*& a, const char*& b, int& n) const { a = A + (size_t)u.pm * tsA; b = B + (size_t)u.pn * tsB; n = nt; }
};
struct SchedInLast {
    StaticOrder o; const char* A; const char* B; size_t tsA, tsB; int nt;
    DI bool next(int i, Unit& u) const {
        const long L = (long)i * o.G + o.c;
        if (L < o.nwg) return o.next(i, u);
        const int e = (int)(L - o.nwg); if (e >= HB * 11) return false;
        const int bl = e / 11, k = e - bl * 11;
        u.pm = bl * TPB; u.pn = k < 4 ? 2 + k : (k == 4 ? 10 : 8 + k); u.br = 0; return true;
    }
    DI void locate(const Unit& u, const char*& a, const char*& b, int& n) const { a = A + (size_t)u.pm * tsA; b = B + (size_t)u.pn * tsB; n = nt; }
};
struct Sched3 {
    StaticOrder o; const char* A; const char* B; size_t tsA, tsB;
    DI bool next(int i, Unit& u) const { const int j = i / 3; if (!o.next(j, u)) return false; u.br = i - 3 * j; return true; }
    DI void locate(const Unit& u, const char*& a, const char*& b, int& n) const {
        const int koff = u.br == 0 ? 0 : (u.br == 1 ? 512 : 1024);
        a = A + (size_t)u.pm * tsA + koff * 2; b = B + (size_t)u.pn * tsB + koff * 2; n = u.br == 2 ? 16 : 8; }
};

template <class Epi, class Sched>
DI void gemm_phase(LAS unsigned char* lds, int lda, int ldb, const Sched& S, const Epi& E) {
    const int tid = lv(threadIdx.x), wid = __builtin_amdgcn_readfirstlane(tid >> 6), lane = tid & 63, wr = wid >> 2, wc = wid & 3, fr = lane & 15, fq = lane >> 4;
    unsigned voffA[2], voffB[2];
#pragma unroll
    for (int i = 0; i < 2; ++i) { int R, C; stage_rc(tid * 16 + i * 8192, R, C); const int Rb = Epi::PERM ? ((R & ~31) + perm32(R & 31)) : R; voffA[i] = (unsigned)(R * lda + C) * 2u; voffB[i] = (unsigned)(Rb * ldb + C) * 2u; }
    const size_t kstep = (size_t)(BK * 2);
    const size_t hsA = (size_t)HALF * lda * 2, hsB = (size_t)HALF * ldb * 2;
    const unsigned ldsw = (unsigned)wid * 1024u;
    const int aoff = lds_byte(wr * 64 + fr, fq * 8), boff = lds_byte(wc * 32 + fr, fq * 8);
#define PG8_SA(b, h) (((b) * 2 + (h)) * HTB)
#define PG8_SB(b, h) ((4 + (b) * 2 + (h)) * HTB)
#define PG8_STAGE(bufoff, gbase, voff) do { _Pragma("unroll") for (int _i = 0; _i < 2; ++_i) \
        __builtin_amdgcn_global_load_lds((const unsigned*)((const char*)(gbase) + (voff)[_i]), (LAS unsigned*)(lds + (bufoff) + ldsw + _i * 8192), 16, 0, 0); } while (0)
#define PG8_LDA(dst, b, h) do { _Pragma("unroll") for (int m = 0; m < 4; ++m) _Pragma("unroll") for (int k = 0; k < 2; ++k) dst[m][k] = *(const LAS bf16x8*)(lds + PG8_SA(b, h) + aoff + m * 2048 + k * 1024); } while (0)
#define PG8_LDB(dst, b, h) do { _Pragma("unroll") for (int n = 0; n < 2; ++n) _Pragma("unroll") for (int k = 0; k < 2; ++k) dst[n][k] = *(const LAS bf16x8*)(lds + PG8_SB(b, h) + boff + n * 2048 + k * 1024); } while (0)
#define PG8_MMA(ai, bj, At, Bt) do { __builtin_amdgcn_s_setprio(1); _Pragma("unroll") for (int m = 0; m < 4; ++m) _Pragma("unroll") for (int n = 0; n < 2; ++n) _Pragma("unroll") for (int k = 0; k < 2; ++k) \
        acc[ai][bj][m][n] = __builtin_amdgcn_mfma_f32_16x16x32_bf16(Bt[n][k], At[m][k], acc[ai][bj][m][n], 0, 0, 0); __builtin_amdgcn_s_setprio(0); } while (0)
#define PG8_WAIT_V(n) asm volatile("s_waitcnt vmcnt(" #n ")" ::: "memory")
#define PG8_WAIT_L(n) asm volatile("s_waitcnt lgkmcnt(" #n ")" ::: "memory")
#define PG8_BAR __builtin_amdgcn_s_barrier()
#define PG8_SCHED __builtin_amdgcn_sched_barrier(0)
    Unit cur, nxt; int ui = 0;
    if (!S.next(0, cur)) return;
    f32x4 acc[2][2][4][2];
#pragma unroll
    for (int a = 0; a < 2; ++a)
#pragma unroll
        for (int b = 0; b < 2; ++b)
#pragma unroll
            for (int m = 0; m < 4; ++m)
#pragma unroll
                for (int n = 0; n < 2; ++n) acc[a][b][m][n] = (f32x4){0.f, 0.f, 0.f, 0.f};
    bf16x8 At[4][2], B0[2][2], B1[2][2];
    const char* cA; const char* cB; int nt; S.locate(cur, cA, cB, nt);
    PG8_STAGE(PG8_SB(0, 0), cB, voffB); PG8_STAGE(PG8_SB(0, 1), cB + hsB, voffB); PG8_STAGE(PG8_SA(0, 0), cA, voffA); PG8_STAGE(PG8_SA(0, 1), cA + hsA, voffA);
    if (wr == 1) PG8_BAR;
    PG8_WAIT_V(2); PG8_BAR;
    PG8_STAGE(PG8_SB(1, 0), cB + kstep, voffB); PG8_STAGE(PG8_SA(1, 0), cA + kstep, voffA); PG8_STAGE(PG8_SB(1, 1), cB + hsB + kstep, voffB);
    PG8_WAIT_V(6); PG8_BAR;
    for (;;) {
        const bool has_next = S.next(ui + 1, nxt);
        const char* nA = cA; const char* nB = cB; int nnt = nt;
        if (has_next) S.locate(nxt, nA, nB, nnt);
        for (int t = 0; t < nt; t += 2) {
            const bool last = (t == nt - 2);
            const char* a1 = cA + (size_t)(t + 1) * kstep;
            const char* a2 = last ? nA : cA + (size_t)(t + 2) * kstep; const char* b2 = last ? nB : cB + (size_t)(t + 2) * kstep;
            const char* a3 = a2 + kstep; const char* b3 = b2 + kstep;
            PG8_LDB(B0, 0, 0); PG8_LDB(B1, 0, 1); PG8_SCHED; PG8_LDA(At, 0, 0); PG8_STAGE(PG8_SA(1, 1), a1 + hsA, voffA);
            PG8_WAIT_V(8); PG8_WAIT_L(0); PG8_BAR; PG8_MMA(0, 0, At, B0); PG8_MMA(0, 1, At, B1); PG8_BAR; PG8_SCHED;
            PG8_LDA(At, 0, 1); PG8_STAGE(PG8_SB(0, 0), b2, voffB); PG8_STAGE(PG8_SB(0, 1), b2 + hsB, voffB); PG8_STAGE(PG8_SA(0, 0), a2, voffA);
            PG8_WAIT_V(8); PG8_WAIT_L(0); PG8_BAR; PG8_MMA(1, 0, At, B0); PG8_MMA(1, 1, At, B1); PG8_BAR; PG8_SCHED;
            PG8_LDB(B0, 1, 0); PG8_LDB(B1, 1, 1); PG8_SCHED; PG8_LDA(At, 1, 0); PG8_STAGE(PG8_SA(0, 1), a2 + hsA, voffA);
            PG8_WAIT_V(8); PG8_WAIT_L(0); PG8_BAR; PG8_MMA(0, 0, At, B0); PG8_MMA(0, 1, At, B1); PG8_BAR; PG8_SCHED;
            PG8_LDA(At, 1, 1); PG8_STAGE(PG8_SB(1, 0), b3, voffB); PG8_STAGE(PG8_SB(1, 1), b3 + hsB, voffB); PG8_STAGE(PG8_SA(1, 0), a3, voffA);
            PG8_WAIT_V(8); PG8_WAIT_L(0); PG8_BAR; PG8_MMA(1, 0, At, B0); PG8_MMA(1, 1, At, B1); PG8_BAR; PG8_SCHED;
        }
        if (wr == 0) PG8_BAR;
        E(acc, cur, wr, wc, fr, fq);
        if (!has_next) break;
#pragma unroll
        for (int a = 0; a < 2; ++a)
#pragma unroll
            for (int b = 0; b < 2; ++b)
#pragma unroll
                for (int m = 0; m < 4; ++m)
#pragma unroll
                    for (int n = 0; n < 2; ++n) acc[a][b][m][n] = (f32x4){0.f, 0.f, 0.f, 0.f};
        cur = nxt; cA = nA; cB = nB; nt = nnt; ++ui;
        if (wr == 1) PG8_BAR;
    }
    PG8_WAIT_V(0);
    PG8_BAR;
#undef PG8_SA
#undef PG8_SB
#undef PG8_STAGE
#undef PG8_LDA
#undef PG8_LDB
#undef PG8_MMA
#undef PG8_WAIT_V
#undef PG8_WAIT_L
#undef PG8_BAR
#undef PG8_SCHED
}
}
using pg8::Unit;

typedef f32x4 Acc[2][2][4][2];

struct EpiIn {
    static constexpr bool PERM = true;
    unsigned char* ws; const float* tab; const float* mcw;
    DI void conv_tile(const Acc& acc, const Unit& u, int wr, int wc, int fr, int fq) const {
        const int which = u.pn >> 1;
        bf16_t* dst = (bf16_t*)(ws + (which ? PO_MKC : PO_MQC)); bf16_t* SQ = (bf16_t*)(ws + WS_SQ);
        const float sc = which ? 0.08838834764831845f : 1.f;
#pragma unroll
        for (int bj = 0; bj < 2; ++bj) {
            const int c0 = (u.pn & 1) * 256 + bj * 128 + wc * 32 + fq * 8;
            f32x4 w0[2], w1[2], w2[2];
#pragma unroll
            for (int n = 0; n < 2; ++n) { const float* cw = mcw + which * 512 + c0 + 4 * n; w0[n] = *(const GAS f32x4*)cw; w1[n] = *(const GAS f32x4*)(cw + 1024); w2[n] = *(const GAS f32x4*)(cw + 2048); }
#pragma unroll
            for (int ai = 0; ai < 2; ++ai) {
                const size_t rb = (size_t)u.pm * 256 + ai * 128 + wr * 64; const size_t blk = rb >> 6;
                f32x4 rprev[2], lcur[2];
#pragma unroll
                for (int n = 0; n < 2; ++n)
#pragma unroll
                    for (int e = 0; e < 4; ++e) { rprev[n][e] = 0.f; lcur[n][e] = ror15(acc[ai][bj][0][n][e]); }
#pragma unroll
                for (int m = 0; m < 4; ++m) {
                    u32x2 pk[2];
#pragma unroll
                    for (int n = 0; n < 2; ++n) {
                        const f32x4 a = acc[ai][bj][m][n];
                        f32x4 rcur, lnext, o;
#pragma unroll
                        for (int e = 0; e < 4; ++e) { rcur[e] = ror1(a[e]); lnext[e] = m < 3 ? ror15(acc[ai][bj][m < 3 ? m + 1 : 3][n][e]) : 0.f; }
#pragma unroll
                        for (int e = 0; e < 4; ++e) { const float pv = fr > 0 ? rcur[e] : rprev[n][e], nx = fr < 15 ? lcur[n][e] : lnext[e];
                            o[e] = siluf_(w0[n][e] * pv + w1[n][e] * a[e] + w2[n][e] * nx) * sc; }
                        pk[n] = pack4(o); rprev[n] = rcur; lcur[n] = lnext;
                    }
                    const bool edge = (m == 0 && fr == 0) || (m == 3 && fr == 15);
                    if (!edge) *(GAS u32x4*)(dst + (rb + 16 * m + fr) * 512 + c0) = (u32x4){pk[0].x, pk[0].y, pk[1].x, pk[1].y};
                    if ((m == 0 && fr < 2) || (m == 3 && fr >= 14)) {
                        const int slot = m == 0 ? fr : fr - 12;
                        const u32x2 a0 = pack4(acc[ai][bj][m][0]), a1 = pack4(acc[ai][bj][m][1]);
                        *(GAS u32x4*)(SQ + (blk * 4 + slot) * 1024 + which * 512 + c0) = (u32x4){a0.x, a0.y, a1.x, a1.y};
                    }
                }
            }
        }
    }
    DI void operator()(const Acc& acc, const Unit& u, int wr, int wc, int fr, int fq) const {
        fr = lv(fr); fq = lv(fq); wr = ls(wr); wc = ls(wc);
        const int pn = u.pn, jt = u.pm % TPB; const bool is_ctx = (jt == 0);
        if (pn < 4) { conv_tile(acc, u, wr, wc, fr, fq); return; }
#pragma unroll
        for (int bj = 0; bj < 2; ++bj) {
            size_t off; int ld, col, act; float scale = 1.f;
            if (pn < 2) { off = PO_MQ; ld = 512; col = pn * 256; act = 0; }
            else if (pn < 4) { off = PO_MK; ld = 512; col = (pn - 2) * 256; act = 0; }
            else if (pn < 6) { off = PO_MV; ld = 512; col = (pn - 4) * 256; act = 0; }
            else if (pn < 8) { off = PO_MO; ld = 512; col = (pn - 6) * 256; act = 1; }
            else if (pn < 10) { off = PO_AQ; ld = 512; col = (pn - 8) * 256; act = 3; scale = 0.125f * 1.4426950408889634f; }
            else if (pn == 10) { if (bj == 0) { off = PO_AK; ld = 128; col = -128 * bj; act = 3; } else { off = PO_AV; ld = 128; col = -128; act = 0; } }
            else if (pn < 13) { off = PO_RQ; ld = 512; col = (pn - 11) * 256; act = 4; }
            else if (pn < 15) { off = PO_RK; ld = 512; col = (pn - 13) * 256; act = 4; scale = 0.08838834764831845f; }
            else if (pn < 19) { off = PO_RV; ld = 1024; col = (pn - 15) * 256; act = 0; }
            else if (pn < 23) { off = PO_RG; ld = 1024; col = (pn - 19) * 256; act = 2; }
            else { off = PO_G3; ld = 3072; col = (pn - 23) * 256; act = 1; }
            bf16_t* dst = (bf16_t*)(ws + off);
            const int c0 = col + bj * 128 + wc * 32 + fq * 8;
#pragma unroll
            for (int ai = 0; ai < 2; ++ai)
#pragma unroll
                for (int m = 0; m < 4; ++m) {
                    const int rit = ai * 128 + wr * 64 + m * 16 + fr;
                    const size_t r = (size_t)u.pm * 256 + rit;
                    f32x4 v0 = acc[ai][bj][m][0], v1 = acc[ai][bj][m][1];
                    if (act == 1) {
#pragma unroll
                        for (int e = 0; e < 4; ++e) { v0[e] = sigmoidf_(v0[e]); v1[e] = sigmoidf_(v1[e]); }
                    } else if (act == 2) {
#pragma unroll
                        for (int e = 0; e < 4; ++e) { v0[e] = siluf_(v0[e]); v1[e] = siluf_(v1[e]); }
                    } else if (act == 3) {
                        if (!is_ctx) {
                            const int t = (jt - 1) * 256 + rit; const int posv = (wc & 1) ? (t & 63) : (t >> 6);
                            const f32x4 cs = *(const GAS f32x4*)(tab + TAB_COSA + posv * 16 + fq * 4), sn = *(const GAS f32x4*)(tab + TAB_SINA + posv * 16 + fq * 4);
                            const f32x4 a = v0 * cs - v1 * sn, b = v0 * sn + v1 * cs; v0 = a; v1 = b;
                        }
                        v0 = v0 * scale; v1 = v1 * scale;
                    } else if (act == 4) {
                        const int p = jt * 256 + rit;
                        const f32x4 cs = *(const GAS f32x4*)(tab + TAB_COSR + p * 64 + wc * 16 + fq * 4), sn = *(const GAS f32x4*)(tab + TAB_SINR + p * 64 + wc * 16 + fq * 4);
                        const f32x4 a = v0 * cs - v1 * sn, b = v0 * sn + v1 * cs; v0 = a * scale; v1 = b * scale;
                    }
                    bf16_t* rp = dst + r * ld + c0;
                    { const u32x2 p0 = pack4(v0), p1 = pack4(v1); *(GAS u32x4*)rp = (u32x4){p0.x, p0.y, p1.x, p1.y}; }
                    asm volatile("" ::: "memory");
                }
        }
    }
};
struct EpiBr {
    static constexpr bool PERM = true;
    bf16_t* Z; const bf16_t* G3;
    DI void operator()(const Acc& acc, const Unit& u, int wr, int wc, int fr, int fq) const {
        fr = lv(fr); fq = lv(fq); wr = ls(wr); wc = ls(wc);
        const int br = u.br;
#pragma unroll
        for (int ai = 0; ai < 2; ++ai) {
            u32x4 gw[4][2], zo[4][2];
#pragma unroll
            for (int m = 0; m < 4; ++m) {
                const size_t r = (size_t)u.pm * 256 + ai * 128 + wr * 64 + m * 16 + fr;
#pragma unroll
                for (int bj = 0; bj < 2; ++bj) {
                    const int c = u.pn * 256 + bj * 128 + wc * 32 + fq * 8;
                    gw[m][bj] = *(const GAS u32x4*)(G3 + r * 3072 + br * 1024 + c);
                    if (br > 0) zo[m][bj] = *(const GAS u32x4*)(Z + r * 1024 + c);
                }
            }
            __builtin_amdgcn_sched_barrier(0);
#pragma unroll
            for (int m = 0; m < 4; ++m) {
                const size_t r = (size_t)u.pm * 256 + ai * 128 + wr * 64 + m * 16 + fr;
#pragma unroll
                for (int bj = 0; bj < 2; ++bj) {
                    const int c = u.pn * 256 + bj * 128 + wc * 32 + fq * 8;
                    const u32x4 g4 = gw[m][bj];
                    f32x4 z0 = unpack4((u32x2){g4.x, g4.y}) * acc[ai][bj][m][0], z1 = unpack4((u32x2){g4.z, g4.w}) * acc[ai][bj][m][1];
                    if (br > 0) { const u32x4 z4 = zo[m][bj]; z0 = z0 + unpack4((u32x2){z4.x, z4.y}); z1 = z1 + unpack4((u32x2){z4.z, z4.w}); }
                    const u32x2 p0 = pack4(z0), p1 = pack4(z1);
                    *(GAS u32x4*)(Z + r * 1024 + c) = (u32x4){p0.x, p0.y, p1.x, p1.y};
                }
            }
            __builtin_amdgcn_sched_barrier(0);
        }
    }
};
struct EpiRes {
    static constexpr bool PERM = true;
    const float* x_in; const float* ctx_in; float* out; float* xc; const float* gate; int half, first, skip_ctx;
    DI void operator()(const Acc& acc, const Unit& u, int wr, int wc, int fr, int fq) const {
        fr = lv(fr); fq = lv(fq); wr = ls(wr); wc = ls(wc);
        const int bl = u.pm / TPB, jt = u.pm - bl * TPB, b = half * HB + bl; const bool is_ctx = (jt == 0);
        if (is_ctx && skip_ctx) return;
        const float* gr = gate + (size_t)(is_ctx ? 16 : b) * 6144;
        f32x4 g[2][2];
#pragma unroll
        for (int bj = 0; bj < 2; ++bj)
#pragma unroll
            for (int n = 0; n < 2; ++n) g[bj][n] = *(const GAS f32x4*)(gr + u.pn * 256 + bj * 128 + wc * 32 + fq * 8 + n * 4);
        float* const dbase = is_ctx ? xc : out;
        const float* const bbase = first ? (is_ctx ? ctx_in : x_in) : (const float*)dbase;
        const size_t rbase0 = is_ctx ? (size_t)b * CTX : (size_t)b * SEQ + (jt - 1) * 256;
#pragma unroll
        for (int ai = 0; ai < 2; ++ai)
#pragma unroll
        for (int mh = 0; mh < 2; ++mh) {
            f32x4 xs[2][2][2];
#pragma unroll
            for (int m2 = 0; m2 < 2; ++m2) {
                const int rit = ai * 128 + wr * 64 + (mh * 2 + m2) * 16 + fr;
                const float* bp = bbase + (rbase0 + rit) * D;
#pragma unroll
                for (int bj = 0; bj < 2; ++bj)
#pragma unroll
                    for (int n = 0; n < 2; ++n) xs[m2][bj][n] = *(const GAS f32x4*)(bp + u.pn * 256 + bj * 128 + wc * 32 + fq * 8 + n * 4);
            }
            __builtin_amdgcn_sched_barrier(0);
#pragma unroll
            for (int m2 = 0; m2 < 2; ++m2) {
                const int m = mh * 2 + m2;
                const int rit = ai * 128 + wr * 64 + m * 16 + fr;
                float* dp = dbase + (rbase0 + rit) * D;
#pragma unroll
                for (int bj = 0; bj < 2; ++bj)
#pragma unroll
                    for (int n = 0; n < 2; ++n) *(GAS f32x4*)(dp + u.pn * 256 + bj * 128 + wc * 32 + fq * 8 + n * 4) = xs[m2][bj][n] + g[bj][n] * acc[ai][bj][m][n];
            }
            __builtin_amdgcn_sched_barrier(0);
        }
    }
};
struct EpiUp {
    static constexpr bool PERM = true;
    bf16_t* U; bf16_t* SA; bf16_t* SB; const float* cw; const float* cb;
    DI void operator()(const Acc& acc, const Unit& u, int wr, int wc, int fr, int fq) const {
        fr = lv(fr); fq = lv(fq); wr = ls(wr); wc = ls(wc);
        const int lane = fq * 16 + fr, c0 = u.pn * 128 + wc * 32 + fq * 8;
        f32x4 w0[2], w1[2], w2[2], bs[2];
#pragma unroll
        for (int n = 0; n < 2; ++n) { w0[n] = *(const GAS f32x4*)(cw + c0 + 4 * n); w1[n] = *(const GAS f32x4*)(cw + FFN + c0 + 4 * n); w2[n] = *(const GAS f32x4*)(cw + 2 * FFN + c0 + 4 * n); bs[n] = *(const GAS f32x4*)(cb + c0 + 4 * n); }
#pragma unroll
        for (int ai = 0; ai < 2; ++ai) {
            const size_t rb = (size_t)u.pm * 256 + ai * 128 + wr * 64;
            const size_t blk = rb >> 6;
            f32x4 rprev[2], lcur[2];
#pragma unroll
            for (int n = 0; n < 2; ++n)
#pragma unroll
                for (int e = 0; e < 4; ++e) { rprev[n][e] = 0.f; lcur[n][e] = ror15(acc[ai][0][0][n][e]); }
#pragma unroll
            for (int m = 0; m < 4; ++m) {
                u32x2 pk[2];
#pragma unroll
                for (int n = 0; n < 2; ++n) {
                    const f32x4 a = acc[ai][0][m][n], b = acc[ai][1][m][n];
                    f32x4 rcur, lnext;
#pragma unroll
                    for (int e = 0; e < 4; ++e) { rcur[e] = ror1(a[e]); lnext[e] = m < 3 ? ror15(acc[ai][0][m < 3 ? m + 1 : 3][n][e]) : 0.f; }
                    f32x4 o;
#pragma unroll
                    for (int e = 0; e < 4; ++e) {
                        const float pv = fr > 0 ? rcur[e] : rprev[n][e], nx = fr < 15 ? lcur[n][e] : lnext[e];
                        o[e] = siluf_(w0[n][e] * pv + w1[n][e] * a[e] + w2[n][e] * nx + bs[n][e]) * b[e];
                    }
                    pk[n] = pack4(o);
                    rprev[n] = rcur; lcur[n] = lnext;
                }
                const bool edge = (m == 0 && fr == 0) || (m == 3 && fr == 15);
                if (!edge) *(GAS u32x4*)(U + (rb + 16 * m + fr) * FFN + c0) = (u32x4){pk[0].x, pk[0].y, pk[1].x, pk[1].y};
                if (m == 0 || m == 3) {
                    const int slot = m == 0 ? fr : fr - 12;
                    if (slot >= 0 && slot < 4 && (m == 0 ? fr < 2 : fr >= 14)) {
                        const u32x2 a0 = pack4(acc[ai][0][m][0]), a1 = pack4(acc[ai][0][m][1]);
                        *(GAS u32x4*)(SA + (blk * 4 + slot) * FFN + c0) = (u32x4){a0.x, a0.y, a1.x, a1.y};
                        if (edge) { const u32x2 b0 = pack4(acc[ai][1][m][0]), b1 = pack4(acc[ai][1][m][1]);
                            *(GAS u32x4*)(SB + (blk * 2 + (m == 3)) * FFN + c0) = (u32x4){b0.x, b0.y, b1.x, b1.y}; }
                    }
                }
            }
        }
    }
};
struct MixArgs { unsigned char* ws; const float* conv_w; const float* sink; const float* ret_logit; int need_ctx; };
DI bf16x8 ldfrag(const LAS unsigned char* p) { return *(const LAS bf16x8*)p; }
DI bf16x8 trfrag(const LAS unsigned char* p, int off2) {
    const s16x4 a = __builtin_amdgcn_ds_read_tr16_b64_v4i16((LAS s16x4*)p);
    const s16x4 b = __builtin_amdgcn_ds_read_tr16_b64_v4i16((LAS s16x4*)(p + off2));
    return (bf16x8){a[0], a[1], a[2], a[3], b[0], b[1], b[2], b[3]};
}
DI bf16x8 pack8(f32x4 a, f32x4 b) { u32x4 w; w.x = cvt_pk_bf16(a[0], a[1]); w.y = cvt_pk_bf16(a[2], a[3]); w.z = cvt_pk_bf16(b[0], b[1]); w.w = cvt_pk_bf16(b[2], b[3]); return __builtin_bit_cast(bf16x8, w); }
#define MFMA16(a, b, c) __builtin_amdgcn_mfma_f32_16x16x32_bf16(a, b, c, 0, 0, 0)

constexpr int LROW = 288, BROW = 272;

constexpr int L_QS = 0, L_KS = 17408, L_KWS = 34816, L_VS = 53248, L_CS = 71680, L_SC = 110848;
template <bool ML>
DI void linattn_unit(LAS unsigned char* lds, const MixArgs& A, int bl, int h, int vs, int dir) {
    const int tid = lv(threadIdx.x), wid = __builtin_amdgcn_readfirstlane(tid >> 6), lane = tid & 63, li = lane & 15, qq = lane >> 4;
    constexpr int NVT = ML ? 9 : 8, NX = ML ? 5 : 4;
    const GAS bf16_t* Qg = (const GAS bf16_t*)(A.ws + (ML ? PO_MQC : PO_RQ)) + h * 128;
    const GAS bf16_t* Kg = (const GAS bf16_t*)(A.ws + (ML ? PO_MKC : PO_RK)) + h * 128;
    const int ldv = ML ? 512 : 1024;
    const GAS bf16_t* Vg = (const GAS bf16_t*)(A.ws + (ML ? PO_MV : PO_RV)) + (ML ? h * 128 : h * 256 + vs * 128);
    GAS bf16_t* Og; int ldo;
    if (dir == 0) { Og = (GAS bf16_t*)(A.ws + WS_YCAT) + (ML ? h * 128 : 1024 + h * 256 + vs * 128); ldo = 2048; }
    else if (ML) { Og = (GAS bf16_t*)(A.ws + WS_HMB) + h * 128; ldo = 512; }
    else { Og = (GAS bf16_t*)(A.ws + WS_HRB) + h * 256 + vs * 128; ldo = 1024; }
    const GAS float* MGg = (const GAS float*)(A.ws + PO_MG);
    const size_t row0 = (size_t)bl * PT;
    LAS float* sbm = (LAS float*)(lds + L_SC) + wid * 384; LAS float* su = sbm + 64; LAS float* siw = sbm + 128; LAS float* sw = sbm + 192; LAS float* sem = sbm + 256;
    const int sgq = tid & 15;
    __syncthreads();
    if (ML) {
        if (tid < 64) { LAS unsigned* vp = (LAS unsigned*)(lds + L_VS + tid * LROW + 256); const unsigned zz = (unsigned)lv(0);
#pragma unroll
            for (int e = 0; e < 8; ++e) vp[e] = e == 0 ? (zz | 0x3F80u) : zz; }
    }
    {
        f32x4 cacc[NVT];
#pragma unroll
        for (int t = 0; t < NVT; ++t) cacc[t] = (f32x4){0.f, 0.f, 0.f, 0.f};
        for (int i = tid; i < NVT * 16 * (BROW / 4); i += 512) ((LAS unsigned*)(lds + L_CS))[i] = 0u;
        float m_run = 0.f;
        const float lg = ML ? 0.f : logsigmoidf_(A.ret_logit[dir * 4 + h]);
        u32x4 pq[2], pk[2], pvv[2]; float plf = lg, plii = 0.f;
#define LA_LOAD(CI) do { const int mc_ = dir == 0 ? (CI) : ((CI) < 4 ? 3 - (CI) : 71 - (CI)), p0_ = mc_ * 64; const size_t rb_ = row0 + p0_; \
            if (ML) { const GAS float* g_ = MGg + (rb_ + lane) * 16; plf = g_[(dir ? 12 : 4) + h]; plii = g_[(dir ? 8 : 0) + h]; } \
            _Pragma("unroll") for (int it_ = 0; it_ < 2; ++it_) { const int i_ = (tid + it_ * 512) >> 4; pq[it_] = *(const GAS u32x4*)(Qg + (rb_ + i_) * 512 + sgq * 8); pk[it_] = *(const GAS u32x4*)(Kg + (rb_ + i_) * 512 + sgq * 8); \
                pvv[it_] = *(const GAS u32x4*)(Vg + (rb_ + i_) * ldv + sgq * 8); } } while (0)
        LA_LOAD(0);
        for (int ci = 0; ci < 68; ++ci) {
            const int mc = dir == 0 ? ci : (ci < 4 ? 3 - ci : 71 - ci), p0 = mc * 64;
            const size_t rbase = row0 + p0;
            float decay;
            {
                float b, u, g, cml = 0.f, cm = 0.f;
                if (ML) {
                    const float lf = plf, lii = plii;
                    b = lf;
                    if (dir == 0) {
#pragma unroll
                        for (int o = 1; o < 64; o <<= 1) { const float t = __shfl_up(b, o); if (lane >= o) b += t; }
                    } else {
#pragma unroll
                        for (int o = 1; o < 64; o <<= 1) { const float t = __shfl_down(b, o); if (lane + o < 64) b += t; }
                    }
                    u = lii - b; cm = u;
                    if (dir == 0) {
#pragma unroll
                        for (int o = 1; o < 64; o <<= 1) { const float t = __shfl_up(cm, o); if (lane >= o) cm = fmaxf(cm, t); }
                    } else {
#pragma unroll
                        for (int o = 1; o < 64; o <<= 1) { const float t = __shfl_down(cm, o); if (lane + o < 64) cm = fmaxf(cm, t); }
                    }
                    g = __shfl(b, dir ? 0 : 63); cml = __shfl(cm, dir ? 0 : 63);
                } else {
                    b = (float)(dir ? 64 - lane : lane + 1) * lg; u = -b; g = 64.f * lg;
                }
                float bm, iw, w, em, m_new;
                if (ML) { const float mj = b + fmaxf(m_run, cm); iw = __expf(b + m_run - mj); m_new = g + fmaxf(m_run, cml); w = __expf(g + u - m_new); decay = __expf(g + m_run - m_new); em = __expf(-mj); bm = b - mj; }
                else { bm = b; iw = __expf(b); w = __expf(g + u); decay = __expf(g); em = 1.f; m_new = 0.f; }
                sbm[lane] = bm; su[lane] = u; siw[lane] = iw; sw[lane] = w; sem[lane] = em;
                m_run = m_new;
            }
#pragma unroll
            for (int it = 0; it < 2; ++it) {
                const int idx = tid + it * 512, i = idx >> 4, sg = sgq; const float wi = sw[i];
                const u32x4 ko = pk[it]; u32x4 kwo;
#pragma unroll
                for (int e = 0; e < 4; ++e) kwo[e] = cvt_pk_bf16(bflo(ko[e]) * wi, bfhi(ko[e]) * wi);
                *(LAS u32x4*)(lds + L_QS + i * BROW + sg * 16) = pq[it]; *(LAS u32x4*)(lds + L_KS + i * BROW + sg * 16) = ko; *(LAS u32x4*)(lds + L_KWS + i * LROW + sg * 16) = kwo;
                *(LAS u32x4*)(lds + L_VS + i * LROW + sg * 16) = pvv[it];
            }
            if (ci + 1 < 68) LA_LOAD(ci + 1);
            __syncthreads();
            {
                const int jt = wid & 3, dg = wid >> 2, j = 16 * jt + li;
                bf16x8 qf[4];
#pragma unroll
                for (int ks = 0; ks < 4; ++ks) qf[ks] = ldfrag(lds + L_QS + j * BROW + (32 * ks + 8 * qq) * 2);
                f32x4 s[4];
#pragma unroll
                for (int rt = 0; rt < 4; ++rt) { s[rt] = (f32x4){0.f, 0.f, 0.f, 0.f};
#pragma unroll
                    for (int ks = 0; ks < 4; ++ks) s[rt] = MFMA16(ldfrag(lds + L_KS + (16 * rt + li) * BROW + (32 * ks + 8 * qq) * 2), qf[ks], s[rt]); }
                const float bmj = sbm[j];
#pragma unroll
                for (int rt = 0; rt < 4; ++rt) { const f32x4 u4 = *(const LAS f32x4*)(su + 16 * rt + 4 * qq);
#pragma unroll
                    for (int e = 0; e < 4; ++e) { const int r = 16 * rt + 4 * qq + e; const bool ok = dir ? (r >= j) : (r <= j); s[rt][e] = ok ? s[rt][e] * __expf(bmj + u4[e]) : 0.f; } }
                bf16x8 pf[2];
                pf[0] = pack8(s[0], s[1]); pf[1] = pack8(s[2], s[3]);
                f32x4 o[NX];
                const float iw = siw[j];
#pragma unroll
                for (int x = 0; x < NX; ++x) {
                    const int dvt = x < 4 ? 4 * dg + x : 8;
                    f32x4 oo = (f32x4){0.f, 0.f, 0.f, 0.f}, itr = oo;
#pragma unroll
                    for (int kk = 0; kk < 2; ++kk) oo = MFMA16(trfrag(lds + L_VS + (32 * kk + 4 * qq + (li >> 2)) * LROW + (16 * dvt + 4 * (li & 3)) * 2, 16 * LROW), pf[kk], oo);
#pragma unroll
                    for (int ks = 0; ks < 4; ++ks) itr = MFMA16(ldfrag(lds + L_CS + (16 * dvt + li) * BROW + (32 * ks + 8 * qq) * 2), qf[ks], itr);
                    o[x] = oo + itr * iw;
                }
                if (ML) {
                    const float den = __shfl(o[NX - 1][0], li);
                    const float inv = __builtin_amdgcn_rcpf(fmaxf(fabsf(den), sem[j]));
#pragma unroll
                    for (int x = 0; x < 4; ++x) o[x] = o[x] * inv;
                }
                if (A.need_ctx || p0 >= CTX) {
#pragma unroll
                    for (int x = 0; x < 4; ++x) *(GAS u32x2*)(Og + (rbase + j) * ldo + 16 * (4 * dg + x) + 4 * qq) = pack4(o[x]);
                }
                bf16x8 kwf[2];
#pragma unroll
                for (int kk = 0; kk < 2; ++kk) kwf[kk] = trfrag(lds + L_KWS + (32 * kk + 4 * qq + (li >> 2)) * LROW + (16 * wid + 4 * (li & 3)) * 2, 16 * LROW);
#pragma unroll
                for (int t = 0; t < NVT; ++t) { cacc[t] = cacc[t] * decay;
#pragma unroll
                    for (int kk = 0; kk < 2; ++kk) cacc[t] = MFMA16(kwf[kk], trfrag(lds + L_VS + (32 * kk + 4 * qq + (li >> 2)) * LROW + (16 * t + 4 * (li & 3)) * 2, 16 * LROW), cacc[t]); }
            }
            __syncthreads();
#pragma unroll
            for (int t = 0; t < NVT; ++t) *(LAS u32x2*)(lds + L_CS + (16 * t + li) * BROW + (16 * wid + 4 * qq) * 2) = pack4(cacc[t]);
        }
        __syncthreads();
    }
#undef LA_LOAD
}

constexpr int A_KROW = 144, A_VROW = 160, A_KT = 0, A_VT = 128 * A_KROW, A_QT = A_VT + 128 * A_VROW;
DI void attn_unit(LAS unsigned char* lds, const MixArgs& A, int bl, int kvh, int qb, int hp, bool ctxq) {
    const int tid = lv(threadIdx.x), wid = __builtin_amdgcn_readfirstlane(tid >> 6), lane = tid & 63, li = lane & 15, qq = lane >> 4;
    const int gq = hp * 2 + (wid >> 2), q32 = wid & 3, head = kvh * 4 + gq;
    const size_t row0 = (size_t)bl * PT;
    const size_t qrow0 = row0 + (ctxq ? 0 : CTX) + qb * 128 + q32 * 32;
    const GAS bf16_t* AQ = (const GAS bf16_t*)(A.ws + PO_AQ); const GAS bf16_t* AK = (const GAS bf16_t*)(A.ws + PO_AK); const GAS bf16_t* AV = (const GAS bf16_t*)(A.ws + PO_AV);
    GAS bf16_t* Og = (GAS bf16_t*)(A.ws + WS_YCAT) + 512 + head * 64;
    const LAS unsigned char* qt = lds + A_QT + wid * 32 * A_KROW;
    __syncthreads();
#pragma unroll
    for (int it = 0; it < 4; ++it) { const int idx = lane + it * 64, row = idx >> 3, sg = idx & 7;
        *(LAS u32x4*)(lds + A_QT + (wid * 32 + row) * A_KROW + sg * 16) = *(const GAS u32x4*)(AQ + (qrow0 + row) * 512 + head * 64 + sg * 8); }
    const float sink = A.sink[head] * 1.4426950408889634f;
    float mrun[2], lsum[2]; f32x4 o[4][2];
#pragma unroll
    for (int jt = 0; jt < 2; ++jt) { mrun[jt] = sink; lsum[jt] = qq == 0 ? 1.f : 0.f;
#pragma unroll
        for (int d = 0; d < 4; ++d) o[d][jt] = (f32x4){0.f, 0.f, 0.f, 0.f}; }
    u32x4 rk[2], rv[2];
#define AT_LOAD(T) do { const size_t kr_ = (T) < 3 ? row0 + CTX + (size_t)(qb - 1 + (T)) * 128 : row0 + (size_t)((T) - 3) * 128; \
        _Pragma("unroll") for (int it_ = 0; it_ < 2; ++it_) { const int idx_ = tid + it_ * 512; \
            rk[it_] = *(const GAS u32x4*)(AK + (kr_ + (idx_ >> 3)) * 128 + kvh * 64 + (idx_ & 7) * 8); rv[it_] = *(const GAS u32x4*)(AV + (kr_ + (idx_ >> 3)) * 128 + kvh * 64 + (idx_ & 7) * 8); } } while (0)
    int tix = ctxq ? 3 : (qb >= 1 ? 0 : 1);
    AT_LOAD(tix);
#pragma unroll 1
    while (tix < 5) {
        int nx = tix + 1; if (nx == 2 && qb == SEQ / 128 - 1) nx = 3;
        const bool local = tix < 3;
        __syncthreads();
#pragma unroll
        for (int it = 0; it < 2; ++it) { const int idx = tid + it * 512;
            *(LAS u32x4*)(lds + A_KT + (idx >> 3) * A_KROW + (idx & 7) * 16) = rk[it]; *(LAS u32x4*)(lds + A_VT + (idx >> 3) * A_VROW + (idx & 7) * 16) = rv[it]; }
        if (nx < 5) AT_LOAD(nx);
        __syncthreads();
#pragma unroll 1
        for (int kh = 0; kh < 2; ++kh) {
        const int kbase = (qb - 1 + tix) * 128 + 64 * kh;
        const int dq = local ? (qb * 128 + q32 * 32 - kbase) : 0; const bool partial = dq < -64 || dq > 96;
        if (dq < 192 && dq > -160) {
            const LAS unsigned char* kt = lds + A_KT + kh * 64 * A_KROW; const LAS unsigned char* vt = lds + A_VT + kh * 64 * A_VROW;
            bf16x8 kfr[4][2], vfr[4][2];
#pragma unroll
            for (int rt = 0; rt < 4; ++rt)
#pragma unroll
                for (int ks = 0; ks < 2; ++ks) kfr[rt][ks] = ldfrag(kt + (16 * rt + li) * A_KROW + (32 * ks + 8 * qq) * 2);
#pragma unroll
            for (int d = 0; d < 4; ++d)
#pragma unroll
                for (int kk = 0; kk < 2; ++kk) vfr[d][kk] = trfrag(vt + (32 * kk + 4 * qq + (li >> 2)) * A_VROW + (16 * d + 4 * (li & 3)) * 2, 16 * A_VROW);
#pragma unroll
            for (int jt = 0; jt < 2; ++jt) {
                bf16x8 qfj[2];
#pragma unroll
                for (int ks = 0; ks < 2; ++ks) qfj[ks] = ldfrag(qt + (16 * jt + li) * A_KROW + (32 * ks + 8 * qq) * 2);
                f32x4 s[4];
#pragma unroll
                for (int rt = 0; rt < 4; ++rt) { s[rt] = (f32x4){0.f, 0.f, 0.f, 0.f};
#pragma unroll
                    for (int ks = 0; ks < 2; ++ks) s[rt] = MFMA16(kfr[rt][ks], qfj[ks], s[rt]); }
                if (partial) {
                    const int qi = qb * 128 + q32 * 32 + 16 * jt + li;
#pragma unroll
                    for (int rt = 0; rt < 4; ++rt)
#pragma unroll
                        for (int e = 0; e < 4; ++e) { const int kj = kbase + 16 * rt + 4 * qq + e; const int dd = qi - kj; if (dd > 128 || dd < -128) s[rt][e] = -1e30f; }
                }
                float tm = s[0][0];
#pragma unroll
                for (int rt = 0; rt < 4; ++rt)
#pragma unroll
                    for (int e = 0; e < 4; ++e) tm = fmaxf(tm, s[rt][e]);
                tm = fmaxf(tm, __shfl_xor(tm, 16)); tm = fmaxf(tm, __shfl_xor(tm, 32));
                const float mn = fmaxf(mrun[jt], tm), alpha = __builtin_amdgcn_exp2f(mrun[jt] - mn); mrun[jt] = mn;
                float ps = 0.f;
#pragma unroll
                for (int rt = 0; rt < 4; ++rt)
#pragma unroll
                    for (int e = 0; e < 4; ++e) { const float p = __builtin_amdgcn_exp2f(s[rt][e] - mn); s[rt][e] = p; ps += p; }
                lsum[jt] = lsum[jt] * alpha + ps;
                bf16x8 pf[2]; pf[0] = pack8(s[0], s[1]); pf[1] = pack8(s[2], s[3]);
#pragma unroll
                for (int d = 0; d < 4; ++d) { f32x4 acc = o[d][jt] * alpha;
#pragma unroll
                    for (int kk = 0; kk < 2; ++kk) acc = MFMA16(vfr[d][kk], pf[kk], acc);
                    o[d][jt] = acc; }
            }
        }
        }
        tix = nx;
    }
#undef AT_LOAD
#pragma unroll
    for (int jt = 0; jt < 2; ++jt) {
        float l = lsum[jt]; l += __shfl_xor(l, 16); l += __shfl_xor(l, 32);
        const float inv = __builtin_amdgcn_rcpf(l);
#pragma unroll
        for (int d = 0; d < 4; ++d) *(GAS u32x2*)(Og + (qrow0 + 16 * jt + li) * 2048 + 16 * d + 4 * qq) = pack4(o[d][jt] * inv);
    }
    __syncthreads();
}

DI void mixer_phase(LAS unsigned char* lds, const MixArgs& A, unsigned* ctr, int sel = 7) {
    const int total = 1216 + (A.need_ctx ? 64 : 0);
    LAS int* slot = (LAS int*)(lds + LDS_BYTES - 16);
    bool first = true;
    for (;;) {
        __syncthreads();
        if (threadIdx.x == 0) *slot = first ? (int)blockIdx.x : (int)(gridDim.x + atomicAdd(ctr, 1u));
        __syncthreads();
        first = false;
        const int u = __builtin_amdgcn_readfirstlane(*slot);
        if (u >= total) break;
        if (u < 64) { if (sel & 1) linattn_unit<true>(lds, A, u >> 3, (u >> 1) & 3, 0, u & 1); }
        else if (u < 192) { const int r = u - 64, within = r & 15, pid = (r >> 4) * 8 + (within & 7), vs = within >> 3;
            if (sel & 2) linattn_unit<false>(lds, A, pid >> 3, (pid >> 1) & 3, vs, pid & 1); }
        else if (u < 1216) { const int v = u - 192; if (sel & 4) attn_unit(lds, A, v >> 7, (v >> 6) & 1, (v >> 1) & 31, v & 1, false); }
        else { const int v = u - 1216; if (sel & 4) attn_unit(lds, A, v >> 3, (v >> 2) & 1, (v >> 1) & 1, v & 1, true); }
    }
}
struct Params { const float* in[24]; float* out; unsigned char* ws; };
enum { I_X = 0, I_C, I_CTX, I_CCTX, I_MODW, I_MODB, I_N1W, I_N2W, I_WIN, I_MGB, I_MCW, I_MNW, I_SINK, I_RLOG, I_RNW, I_BRM, I_BRA, I_BRR, I_WOUT, I_UP, I_FCW, I_FCB, I_DN, I_FNW };

DI int map_in(int n) {
    if (n < 2048) return n;
    if (n < 2064) return -1;
    if (n < 2704) { const int off = n - 2064, blk = off >> 5, w = off & 31, i = w & 15, hi = w >> 4; return 2048 + blk * 32 + 8 * (i >> 2) + 4 * hi + (i & 3); }
    if (n < 2832) return n - 16;
    if (n < 3856) { const int off = n - 2832, head = off >> 7, dim = off & 127, g = (dim & 63) >> 4, idx = dim & 15, hi = dim >> 6; return 2816 + head * 128 + 32 * g + 8 * (idx >> 2) + 4 * hi + (idx & 3); }
    return n - 16;
}
DI int map_up(int n) { const int hb = n >= FFN, s = hb ? n - FFN : n; return (s >> 7) * 256 + hb * 128 + (s & 127); }
DI void transpose_item(const float* W, int K, int N, bf16_t* WT, int ldw, int koff, int mode, LAS float* scr, int item, int lane) {
    const int nblk = (N + 31) / 32, kb = item / nblk, nb = item - kb * nblk, k0 = 64 * kb, n0 = 32 * nb;
    const int nl = n0 + (lane & 31);
    float tv[32];
#pragma unroll
    for (int i = 0; i < 32; ++i) { const int kk = 2 * i + (lane >> 5); tv[i] = nl < N ? W[(size_t)(k0 + kk) * N + nl] : 0.f; }
#pragma unroll
    for (int i = 0; i < 32; ++i) { const int kk = 2 * i + (lane >> 5); scr[kk * 33 + (lane & 31)] = tv[i]; }
    asm volatile("s_waitcnt lgkmcnt(0)" ::: "memory");
    const int c = lane & 7;
#pragma unroll
    for (int j = 0; j < 4; ++j) { const int nn = (lane >> 3) + 8 * j, n = n0 + nn; const LAS float* s = scr + (8 * c) * 33 + nn;
        u32x4 o; o.x = cvt_pk_bf16(s[0 * 33], s[1 * 33]); o.y = cvt_pk_bf16(s[2 * 33], s[3 * 33]); o.z = cvt_pk_bf16(s[4 * 33], s[5 * 33]); o.w = cvt_pk_bf16(s[6 * 33], s[7 * 33]);
        const int dr = n < N ? (mode == 1 ? map_in(n) : (mode == 2 ? map_up(n) : n)) : -1;
        if (dr >= 0) *(GAS u32x4*)(WT + (size_t)dr * ldw + koff + k0 + 8 * c) = o; }
    asm volatile("s_waitcnt lgkmcnt(0)" ::: "memory");
}
DI float wave_sum(float v) {
#pragma unroll
    for (int o = 1; o < 64; o <<= 1) v += __shfl_xor(v, o);
    return v;
}
DI void p0_prologue(const Params& p, LAS unsigned char* lds) {
    const int tid = lv(threadIdx.x), wid = __builtin_amdgcn_readfirstlane(tid >> 6), lane = tid & 63, G = gridDim.x;
    {
        LAS float* scr = (LAS float*)(lds + wid * 8448);
        constexpr int I_IN = 16 * 281, I_BM = 8 * 32, I_BR = 16 * 32, I_O = 16 * 32, I_U = 16 * 176, I_D = 44 * 32, PER = I_IN + 2 * I_BM + I_BR + I_O + I_U + I_D;
        for (int it = blockIdx.x * 8 + wid; it < 2 * PER; it += G * 8) {
            const int l = it / PER; int r = it - l * PER; unsigned char* wb = p.ws + WS_W + (size_t)l * W_LAYER;
            if (r < I_IN) { transpose_item(p.in[I_WIN] + (size_t)l * D * IN_COLS, D, IN_COLS, (bf16_t*)(wb + WO_IN), 1024, 0, 1, scr, r, lane); continue; } r -= I_IN;
            if (r < I_BM) { transpose_item(p.in[I_BRM] + (size_t)l * 512 * D, 512, D, (bf16_t*)(wb + WO_BR), 2048, 0, 0, scr, r, lane); continue; } r -= I_BM;
            if (r < I_BM) { transpose_item(p.in[I_BRA] + (size_t)l * 512 * D, 512, D, (bf16_t*)(wb + WO_BR), 2048, 512, 0, scr, r, lane); continue; } r -= I_BM;
            if (r < I_BR) { transpose_item(p.in[I_BRR] + (size_t)l * D * D, D, D, (bf16_t*)(wb + WO_BR), 2048, 1024, 0, scr, r, lane); continue; } r -= I_BR;
            if (r < I_O) { transpose_item(p.in[I_WOUT] + (size_t)l * D * D, D, D, (bf16_t*)(wb + WO_OUT), 1024, 0, 0, scr, r, lane); continue; } r -= I_O;
            if (r < I_U) { transpose_item(p.in[I_UP] + (size_t)l * D * 2 * FFN, D, 2 * FFN, (bf16_t*)(wb + WO_UP), 1024, 0, 2, scr, r, lane); continue; } r -= I_U;
            transpose_item(p.in[I_DN] + (size_t)l * FFN * D, FFN, D, (bf16_t*)(wb + WO_DN), FFN, 0, 0, scr, r, lane);
        }
    }
    {
        LAS float* st = (LAS float*)lds; LAS float* red = (LAS float*)(lds + 69632);
        float* MOD = (float*)(p.ws + WS_MOD);
        for (int u = blockIdx.x; u < 192; u += G) {
            const int l = u / 96, n0 = (u - l * 96) * 64;
            __syncthreads();
            for (int i = tid; i < 17 * 1024; i += 512) { const int v = i >> 10, k = i & 1023; const float cv = v < 16 ? p.in[I_C][v * 1024 + k] : p.in[I_CCTX][k]; st[i] = cv / (1.f + expf(-cv)); }
            __syncthreads();
            const int col = tid & 63, kp = tid >> 6;
            float acc[17];
#pragma unroll
            for (int v = 0; v < 17; ++v) acc[v] = 0.f;
            const float* wp = p.in[I_MODW] + ((size_t)l * 1024 + kp * 128) * 6144 + n0 + col;
#pragma unroll 16
            for (int k = 0; k < 128; ++k) { const float w = wp[(size_t)k * 6144];
#pragma unroll
                for (int v = 0; v < 17; ++v) acc[v] += st[v * 1024 + kp * 128 + k] * w; }
#pragma unroll
            for (int v = 0; v < 17; ++v) red[(kp * 17 + v) * 64 + col] = acc[v];
            __syncthreads();
            for (int i = tid; i < 17 * 64; i += 512) { const int v = i >> 6, cc = i & 63; float s = 0.f;
#pragma unroll
                for (int q = 0; q < 8; ++q) s += red[(q * 17 + v) * 64 + cc];
                MOD[((size_t)l * 17 + v) * 6144 + n0 + cc] = s + p.in[I_MODB][l * 6144 + n0 + cc]; }
        }
        __syncthreads();
    }
    {
        float* tab = (float*)(p.ws + WS_TAB);
        for (int idx = blockIdx.x * 512 + tid; idx < PT * 64 + 1024; idx += G * 512) {
            int pos, ti; float inv;
            if (idx < PT * 64) { pos = idx >> 6; const int i = idx & 63; inv = exp2f(-(float)i * (13.287712379549449f / 64.f)); ti = idx; }
            else { const int k = idx - PT * 64; pos = k >> 4; const int i = k & 15; inv = exp2f(-(float)i * (13.287712379549449f / 16.f)); ti = k; }
            const double ang = (double)pos * (double)inv; const double rev = ang * 0.15915494309189535; const double fr = rev - __builtin_rint(rev);
            const float a = (float)(fr * 6.283185307179586);
            const float cs = __cosf(a), sn = __sinf(a);
            if (idx < PT * 64) { tab[TAB_COSR + ti] = cs; tab[TAB_SINR + ti] = sn; } else { tab[TAB_COSA + ti] = cs; tab[TAB_SINA + ti] = sn; }
        }
    }
}

DI void norm_phase(const Params& p, LAS unsigned char* lds, int half, int l, int which, int first, int skip_ctx) {
    const int tid = lv(threadIdx.x), wid = __builtin_amdgcn_readfirstlane(tid >> 6), lane = tid & 63, G = gridDim.x;
    LAS float* wg = (LAS float*)lds;
    if (which == 0) {
        __syncthreads();
        const float* win = p.in[I_WIN] + (size_t)l * D * IN_COLS;
        for (int i = tid; i < 16384; i += 512) { const int k = i >> 4, g = i & 15; wg[g * 1024 + k] = win[(size_t)k * IN_COLS + 2048 + g]; }
        __syncthreads();
    }
    const float* MOD = (const float*)(p.ws + WS_MOD);
    const float* nw = p.in[which ? I_N2W : I_N1W] + l * D;
    bf16_t* HN = (bf16_t*)(p.ws + WS_HN);
    float* MG = (float*)(p.ws + PO_MG);
    float* xc = (float*)(p.ws + WS_XC);
#define NP_SRC(R, PTR) do { const int bl_ = (R) / PT, pp_ = (R) - bl_ * PT, b_ = half * HB + bl_; const bool c_ = pp_ < CTX; \
        const size_t ro_ = c_ ? ((size_t)b_ * CTX + pp_) * D : ((size_t)b_ * SEQ + (pp_ - CTX)) * D; \
        PTR = first ? ((c_ ? p.in[I_CTX] : p.in[I_X]) + ro_) : ((c_ ? xc : p.out) + ro_); } while (0)
    f32x4 vn[4];
    { const int r0 = blockIdx.x * 8 + wid; if (r0 < MH) { const float* s0; NP_SRC(r0, s0);
#pragma unroll
        for (int j = 0; j < 4; ++j) vn[j] = *(const GAS f32x4*)(s0 + 4 * (lane + 64 * j)); } }
    for (int r = blockIdx.x * 8 + wid; r < MH; r += G * 8) {
        const int bl = r / PT, pp = r - bl * PT, b = half * HB + bl; const bool is_ctx = pp < CTX;
        f32x4 v[4];
#pragma unroll
        for (int j = 0; j < 4; ++j) v[j] = vn[j];
        { const int r2 = r + G * 8; if (r2 < MH) { const float* s2; NP_SRC(r2, s2);
#pragma unroll
            for (int j = 0; j < 4; ++j) vn[j] = *(const GAS f32x4*)(s2 + 4 * (lane + 64 * j)); } }
        if (is_ctx && skip_ctx) continue;
        const float* mod = MOD + ((size_t)l * 17 + (is_ctx ? 16 : b)) * 6144;
        const float* sh = mod + (which ? 3 : 0) * 1024; const float* sc = mod + (which ? 4 : 1) * 1024;
        float ss = 0.f;
#pragma unroll
        for (int j = 0; j < 4; ++j) ss += v[j][0] * v[j][0] + v[j][1] * v[j][1] + v[j][2] * v[j][2] + v[j][3] * v[j][3];
        const float rstd = rsqrtf(wave_sum(ss) * (1.f / D) + 1e-6f);
#pragma unroll
        for (int j = 0; j < 4; ++j) { const int c = 4 * (lane + 64 * j);
            const f32x4 w4 = *(const GAS f32x4*)(nw + c), s4 = *(const GAS f32x4*)(sc + c), h4 = *(const GAS f32x4*)(sh + c);
            v[j] = v[j] * rstd * w4 * (s4 + 1.f) + h4;
            *(GAS u32x2*)(HN + (size_t)r * D + c) = pack4(v[j]); }
        if (which == 0) {
            float part[16];
#pragma unroll
            for (int g = 0; g < 16; ++g) { float a = 0.f;
#pragma unroll
                for (int j = 0; j < 4; ++j) { const f32x4 w4 = *(const LAS f32x4*)(wg + g * 1024 + 4 * (lane + 64 * j)); a += v[j][0] * w4[0] + v[j][1] * w4[1] + v[j][2] * w4[2] + v[j][3] * w4[3]; }
                part[g] = a; }
            float p8[8], p4[4], p2[2], p1;
            { const bool hi = lane & 32;
#pragma unroll
                for (int j = 0; j < 8; ++j) { const float keep = hi ? part[j + 8] : part[j], send = hi ? part[j] : part[j + 8]; p8[j] = keep + __shfl_xor(send, 32); } }
            { const bool hi = lane & 16;
#pragma unroll
                for (int j = 0; j < 4; ++j) { const float keep = hi ? p8[j + 4] : p8[j], send = hi ? p8[j] : p8[j + 4]; p4[j] = keep + __shfl_xor(send, 16); } }
            { const bool hi = lane & 8;
#pragma unroll
                for (int j = 0; j < 2; ++j) { const float keep = hi ? p4[j + 2] : p4[j], send = hi ? p4[j] : p4[j + 2]; p2[j] = keep + __shfl_xor(send, 8); } }
            { const bool hi = lane & 4; const float keep = hi ? p2[1] : p2[0], send = hi ? p2[0] : p2[1]; p1 = keep + __shfl_xor(send, 4); }
            p1 += __shfl_xor(p1, 1); p1 += __shfl_xor(p1, 2);
            const int gidx = ((lane >> 5) & 1) * 8 + ((lane >> 4) & 1) * 4 + ((lane >> 3) & 1) * 2 + ((lane >> 2) & 1);
            if ((lane & 3) == 0) { float val = p1 + p.in[I_MGB][l * 16 + gidx]; if ((gidx >> 2) & 1) val = logsigmoidf_(val); MG[(size_t)r * 16 + gidx] = val; }
        }
    }
}

DI void postmix_phase(const Params& p, int l, int skip_ctx) {
    const int tid = lv(threadIdx.x), wid = __builtin_amdgcn_readfirstlane(tid >> 6), lane = tid & 63, G = gridDim.x;
    bf16_t* Y = (bf16_t*)(p.ws + WS_YCAT); const bf16_t* MO = (const bf16_t*)(p.ws + PO_MO); const bf16_t* RG = (const bf16_t*)(p.ws + PO_RG);
    const bf16_t* HMB = (const bf16_t*)(p.ws + WS_HMB); const bf16_t* HRB = (const bf16_t*)(p.ws + WS_HRB);
    const float* mnw = p.in[I_MNW] + l * 512; const float* rnw = p.in[I_RNW] + l * 1024;
    float wm[8], wr_[16];
#pragma unroll
    for (int h = 0; h < 2; ++h) { const f32x4 t = *(const GAS f32x4*)(mnw + 8 * lane + 4 * h);
#pragma unroll
        for (int e = 0; e < 4; ++e) wm[4 * h + e] = t[e]; }
#pragma unroll
    for (int h = 0; h < 4; ++h) { const f32x4 t = *(const GAS f32x4*)(rnw + 16 * lane + 4 * h);
#pragma unroll
        for (int e = 0; e < 4; ++e) wr_[4 * h + e] = t[e]; }
    for (int r = blockIdx.x * 8 + wid; r < MH; r += G * 8) {
        const int pp = r % PT; if (pp < CTX && skip_ctx) continue;
        bf16_t* ym = Y + (size_t)r * 2048 + 8 * lane; bf16_t* yr = Y + (size_t)r * 2048 + 1024 + 16 * lane;
        const bf16_t* gp = RG + (size_t)r * 1024 + 16 * lane; const bf16_t* bp = HRB + (size_t)r * 1024 + 16 * lane;
        const u32x4 mraw = *(const GAS u32x4*)ym, mrb = *(const GAS u32x4*)(HMB + (size_t)r * 512 + 8 * lane), mgt = *(const GAS u32x4*)(MO + (size_t)r * 512 + 8 * lane);
        u32x4 raw[2], rb[2], gt[2]; raw[0] = *(const GAS u32x4*)yr; raw[1] = *(const GAS u32x4*)(yr + 8); gt[0] = *(const GAS u32x4*)gp; gt[1] = *(const GAS u32x4*)(gp + 8); rb[0] = *(const GAS u32x4*)bp; rb[1] = *(const GAS u32x4*)(bp + 8);
        {
            float x[8]; float s = 0.f;
#pragma unroll
            for (int e = 0; e < 4; ++e) { x[2 * e] = bflo(mraw[e]) + bflo(mrb[e]); x[2 * e + 1] = bfhi(mraw[e]) + bfhi(mrb[e]); s += x[2 * e] + x[2 * e + 1]; }
            s += __shfl_xor(s, 1); s += __shfl_xor(s, 2); s += __shfl_xor(s, 4); s += __shfl_xor(s, 8);
            const float mu = s * (1.f / 128.f); float q = 0.f;
#pragma unroll
            for (int e = 0; e < 8; ++e) { x[e] -= mu; q += x[e] * x[e]; }
            q += __shfl_xor(q, 1); q += __shfl_xor(q, 2); q += __shfl_xor(q, 4); q += __shfl_xor(q, 8);
            const float rs = rsqrtf(q * (1.f / 128.f) + 1e-6f);
            u32x4 o;
#pragma unroll
            for (int e = 0; e < 4; ++e) { const float a = x[2 * e] * rs * wm[2 * e] * bflo(mgt[e]), b2 = x[2 * e + 1] * rs * wm[2 * e + 1] * bfhi(mgt[e]); o[e] = cvt_pk_bf16(a, b2); }
            *(GAS u32x4*)ym = o;
        }
        {
            float x[16]; float s = 0.f;
#pragma unroll
            for (int e = 0; e < 8; ++e) { x[2 * e] = bflo(raw[e >> 2][e & 3]) + bflo(rb[e >> 2][e & 3]); x[2 * e + 1] = bfhi(raw[e >> 2][e & 3]) + bfhi(rb[e >> 2][e & 3]); s += x[2 * e] + x[2 * e + 1]; }
            s += __shfl_xor(s, 1); s += __shfl_xor(s, 2); s += __shfl_xor(s, 4); s += __shfl_xor(s, 8);
            const float mu = s * (1.f / 256.f); float q = 0.f;
#pragma unroll
            for (int e = 0; e < 16; ++e) { x[e] -= mu; q += x[e] * x[e]; }
            q += __shfl_xor(q, 1); q += __shfl_xor(q, 2); q += __shfl_xor(q, 4); q += __shfl_xor(q, 8);
            const float rs = rsqrtf(q * (1.f / 256.f) + 1e-6f);
            u32x4 o[2];
#pragma unroll
            for (int e = 0; e < 8; ++e) { const float a = x[2 * e] * rs * wr_[2 * e] * bflo(gt[e >> 2][e & 3]), b2 = x[2 * e + 1] * rs * wr_[2 * e + 1] * bfhi(gt[e >> 2][e & 3]); o[e >> 2][e & 3] = cvt_pk_bf16(a, b2); }
            *(GAS u32x4*)yr = o[0]; *(GAS u32x4*)(yr + 8) = o[1];
        }
    }
}

DI void edge_phase(const Params& p, int l, int skip_ctx) {
    const int tid = lv(threadIdx.x), G = gridDim.x;
    const bf16_t* SA = (const bf16_t*)(p.ws + WS_SA); const bf16_t* SB = (const bf16_t*)(p.ws + WS_SB); bf16_t* U = (bf16_t*)(p.ws + WS_FB);
    constexpr int NCG = FFN / 8, NT = (MH / 64) * 2 * NCG;
    for (int t = blockIdx.x * 512 + tid; t < NT; t += G * 512) {
        const int cg = t % NCG, bw = t / NCG, which = bw & 1, blk = bw >> 1, c0 = cg * 8;
        const int r = blk * 64 + (which ? 63 : 0), pp = r % PT;
        if (pp < CTX && skip_ctx) continue;
        const u32x4 z = (u32x4){0u, 0u, 0u, 0u};
        u32x4 ap, ac, an, bb;
        if (!which) { const bool pv = !(pp == 0 || pp == CTX);
            ap = pv ? *(const GAS u32x4*)(SA + ((size_t)(blk - 1) * 4 + 3) * FFN + c0) : z; ac = *(const GAS u32x4*)(SA + ((size_t)blk * 4 + 0) * FFN + c0); an = *(const GAS u32x4*)(SA + ((size_t)blk * 4 + 1) * FFN + c0);
            bb = *(const GAS u32x4*)(SB + ((size_t)blk * 2 + 0) * FFN + c0);
        } else { const bool nv = !(pp + 1 == CTX || pp + 1 == PT);
            ap = *(const GAS u32x4*)(SA + ((size_t)blk * 4 + 2) * FFN + c0); ac = *(const GAS u32x4*)(SA + ((size_t)blk * 4 + 3) * FFN + c0); an = nv ? *(const GAS u32x4*)(SA + ((size_t)(blk + 1) * 4 + 0) * FFN + c0) : z;
            bb = *(const GAS u32x4*)(SB + ((size_t)blk * 2 + 1) * FFN + c0);
        }
        float w0[8], w1[8], w2[8], bs[8];
#pragma unroll
        for (int h = 0; h < 2; ++h) {
            const f32x4 x0 = *(const GAS f32x4*)(p.in[I_FCW] + (l * 3 + 0) * FFN + c0 + 4 * h), x1 = *(const GAS f32x4*)(p.in[I_FCW] + (l * 3 + 1) * FFN + c0 + 4 * h);
            const f32x4 x2 = *(const GAS f32x4*)(p.in[I_FCW] + (l * 3 + 2) * FFN + c0 + 4 * h), xb = *(const GAS f32x4*)(p.in[I_FCB] + l * FFN + c0 + 4 * h);
#pragma unroll
            for (int e = 0; e < 4; ++e) { w0[4 * h + e] = x0[e]; w1[4 * h + e] = x1[e]; w2[4 * h + e] = x2[e]; bs[4 * h + e] = xb[e]; }
        }
        u32x4 o;
#pragma unroll
        for (int e = 0; e < 4; ++e) {
            const float t0 = w0[2 * e] * bflo(ap[e]) + w1[2 * e] * bflo(ac[e]) + w2[2 * e] * bflo(an[e]) + bs[2 * e];
            const float t1 = w0[2 * e + 1] * bfhi(ap[e]) + w1[2 * e + 1] * bfhi(ac[e]) + w2[2 * e + 1] * bfhi(an[e]) + bs[2 * e + 1];
            o[e] = cvt_pk_bf16(siluf_(t0) * bflo(bb[e]), siluf_(t1) * bfhi(bb[e]));
        }
        *(GAS u32x4*)(U + (size_t)r * FFN + c0) = o;
    }
}

DI void qk_edge_phase(const Params& p, int l) {
    const int tid = lv(threadIdx.x), G = gridDim.x;
    const bf16_t* SQ = (const bf16_t*)(p.ws + WS_SQ);
    constexpr int NCG = 128, NT = (MH / 64) * 2 * NCG;
    for (int t = blockIdx.x * 512 + tid; t < NT; t += G * 512) {
        const int cg = t % NCG, bw = t / NCG, wh = bw & 1, blk = bw >> 1, c0 = cg * 8, which = cg >> 6;
        const int r = blk * 64 + (wh ? 63 : 0), pp = r % PT;
        const u32x4 z = (u32x4){0u, 0u, 0u, 0u};
        u32x4 ap, ac, an;
        if (!wh) { const bool pv = !(pp == 0 || pp == CTX);
            ap = pv ? *(const GAS u32x4*)(SQ + ((size_t)(blk - 1) * 4 + 3) * 1024 + c0) : z; ac = *(const GAS u32x4*)(SQ + ((size_t)blk * 4 + 0) * 1024 + c0); an = *(const GAS u32x4*)(SQ + ((size_t)blk * 4 + 1) * 1024 + c0);
        } else { const bool nv = !(pp + 1 == CTX || pp + 1 == PT);
            ap = *(const GAS u32x4*)(SQ + ((size_t)blk * 4 + 2) * 1024 + c0); ac = *(const GAS u32x4*)(SQ + ((size_t)blk * 4 + 3) * 1024 + c0); an = nv ? *(const GAS u32x4*)(SQ + ((size_t)(blk + 1) * 4 + 0) * 1024 + c0) : z;
        }
        const float* cw = p.in[I_MCW] + l * 3 * 1024 + c0;
        float w0[8], w1[8], w2[8];
#pragma unroll
        for (int h = 0; h < 2; ++h) { const f32x4 x0 = *(const GAS f32x4*)(cw + 4 * h), x1 = *(const GAS f32x4*)(cw + 1024 + 4 * h), x2 = *(const GAS f32x4*)(cw + 2048 + 4 * h);
#pragma unroll
            for (int e = 0; e < 4; ++e) { w0[4 * h + e] = x0[e]; w1[4 * h + e] = x1[e]; w2[4 * h + e] = x2[e]; } }
        const float sc = which ? 0.08838834764831845f : 1.f;
        u32x4 o;
#pragma unroll
        for (int e = 0; e < 4; ++e) {
            const float t0 = w0[2 * e] * bflo(ap[e]) + w1[2 * e] * bflo(ac[e]) + w2[2 * e] * bflo(an[e]);
            const float t1 = w0[2 * e + 1] * bfhi(ap[e]) + w1[2 * e + 1] * bfhi(ac[e]) + w2[2 * e + 1] * bfhi(an[e]);
            o[e] = cvt_pk_bf16(siluf_(t0) * sc, siluf_(t1) * sc);
        }
        bf16_t* dst = (bf16_t*)(p.ws + (which ? PO_MKC : PO_MQC));
        *(GAS u32x4*)(dst + (size_t)r * 512 + (c0 & 511)) = o;
    }
}

DI void final_norm_phase(const Params& p, int half) {
    const int tid = lv(threadIdx.x), wid = __builtin_amdgcn_readfirstlane(tid >> 6), lane = tid & 63, G = gridDim.x;
    const float* fw = p.in[I_FNW];
    f32x4 vn[4];
    { const int r0 = blockIdx.x * 8 + wid; if (r0 < HB * SEQ) { const float* s0 = p.out + ((size_t)half * HB * SEQ + r0) * D;
#pragma unroll
        for (int j = 0; j < 4; ++j) vn[j] = *(const GAS f32x4*)(s0 + 4 * (lane + 64 * j)); } }
    for (int r = blockIdx.x * 8 + wid; r < HB * SEQ; r += G * 8) {
        float* xr = p.out + ((size_t)half * HB * SEQ + r) * D;
        f32x4 v[4]; float ss = 0.f;
#pragma unroll
        for (int j = 0; j < 4; ++j) { v[j] = vn[j]; ss += v[j][0] * v[j][0] + v[j][1] * v[j][1] + v[j][2] * v[j][2] + v[j][3] * v[j][3]; }
        { const int r2 = r + G * 8; if (r2 < HB * SEQ) { const float* s2 = p.out + ((size_t)half * HB * SEQ + r2) * D;
#pragma unroll
            for (int j = 0; j < 4; ++j) vn[j] = *(const GAS f32x4*)(s2 + 4 * (lane + 64 * j)); } }
        const float rstd = rsqrtf(wave_sum(ss) * (1.f / D) + 1e-6f);
#pragma unroll
        for (int j = 0; j < 4; ++j) { const f32x4 w4 = *(const GAS f32x4*)(fw + 4 * (lane + 64 * j)); *(GAS f32x4*)(xr + 4 * (lane + 64 * j)) = v[j] * rstd * w4; }
    }
}

#define XB_TMO      128
#define XB_XCNT(j)  (256  + 64 * (j))
#define XB_XSUB(j)  (1280 + 64 * (j))
#define XB_XGEN(j)  (2304 + 64 * (j))
#define XB_TOP      3328
#define XB_TOPGEN   3392
#define XCD_BAR_WORDS 3456
#define XB_SPIN_CAP (1u << 18)

__device__ __forceinline__ unsigned xb_ld(unsigned* p)              { return __hip_atomic_load(p, __ATOMIC_RELAXED, __HIP_MEMORY_SCOPE_AGENT); }
__device__ __forceinline__ unsigned xb_add(unsigned* p, unsigned v) { return __hip_atomic_fetch_add(p, v, __ATOMIC_RELAXED, __HIP_MEMORY_SCOPE_AGENT); }
__device__ __forceinline__ unsigned xb_xcc_id() { return (unsigned)__builtin_amdgcn_s_getreg((3 << 11) | 20) & 0xFu; }
#define XB_SPIN(cond, bar) do { unsigned _sp = 0; while (cond) { __builtin_amdgcn_s_sleep(1); \
    if ((++_sp & 255u) == 0u) { if (xb_ld(&(bar)[XB_TMO])) break; if (_sp > XB_SPIN_CAP) { atomicAdd(&(bar)[XB_TMO], 1u); break; } } } } while (0)

struct XcdBarrier {
    unsigned* bar; unsigned x;
    volatile LAS unsigned* st;
};

__device__ __forceinline__ XcdBarrier xcd_barrier_post(unsigned* bar, volatile LAS unsigned* st) {
    XcdBarrier b; b.bar = bar; b.x = xb_xcc_id(); b.st = st;
    if (threadIdx.x == 0) (void)xb_add(&bar[XB_XCNT(b.x)], 1u);
    return b;
}
__device__ __forceinline__ void xcd_barrier_complete(unsigned* bar, unsigned x, unsigned& nloc, unsigned& nx) {
    const unsigned G = gridDim.x * gridDim.y * gridDim.z;
    unsigned sum, cnt, mine, sp = 0u;
    for (;;) {
        sum = 0u; cnt = 0u; mine = 0u;
#pragma unroll
        for (unsigned j = 0; j < 16; ++j) { const unsigned c = xb_ld(&bar[XB_XCNT(j)]); sum += c; cnt += (c > 0u) ? 1u : 0u; mine = (j == x) ? c : mine; }
        if (sum == G) break;
        __builtin_amdgcn_s_sleep(1);
        if ((++sp & 255u) == 0u) { if (xb_ld(&bar[XB_TMO])) break; if (sp > XB_SPIN_CAP) { atomicAdd(&bar[XB_TMO], 1u); break; } }
    }
    nloc = mine > 0u ? mine : 1u; nx = cnt > 0u ? cnt : 1u;
}

__device__ __forceinline__ void xcd_barrier(const XcdBarrier& b) {
    asm volatile("s_waitcnt vmcnt(0)" ::: "memory");
    __syncthreads();
    if (threadIdx.x == 0) {
        unsigned* bar = b.bar;
        __builtin_amdgcn_s_waitcnt(0);
        unsigned nloc = b.st[0], nx = b.st[1];
        if (nloc == 0u) { xcd_barrier_complete(bar, b.x, nloc, nx); b.st[0] = nloc; b.st[1] = nx; }
        const unsigned old = xb_add(&bar[XB_XSUB(b.x)], 1u);
        const unsigned gen = old / nloc;
        if (old + 1u == (gen + 1u) * nloc) {
            __builtin_amdgcn_fence(__ATOMIC_RELEASE, "agent");
            asm volatile("s_waitcnt vmcnt(0)" ::: "memory");
            const unsigned og = xb_add(&bar[XB_TOP], 1u);
            const unsigned tg = og / nx;
            if (og + 1u == (tg + 1u) * nx) xb_add(&bar[XB_TOPGEN], 1u);
            else XB_SPIN(xb_ld(&bar[XB_TOPGEN]) == tg, bar);
            __builtin_amdgcn_fence(__ATOMIC_ACQUIRE, "agent");
            xb_add(&bar[XB_XGEN(b.x)], 1u);
            asm volatile("s_waitcnt vmcnt(0)" ::: "memory");
        } else {
            XB_SPIN(xb_ld(&bar[XB_XGEN(b.x)]) == gen, bar);
            __builtin_amdgcn_fence(__ATOMIC_ACQUIRE, "agent");
            asm volatile("s_waitcnt vmcnt(0)" ::: "memory");
        }
    }
    __syncthreads();
}


constexpr int CW_BAR = 4096;
__global__ void __launch_bounds__(512, 2) mk_fwd(Params p) {
    extern __shared__ __attribute__((aligned(16))) unsigned char lds_raw[];
    LAS unsigned char* lds = (LAS unsigned char*)lds_raw;
    cg::grid_group grid = cg::this_grid();
    volatile LAS unsigned* bst = (volatile LAS unsigned*)(lds + LDS_BYTES - 32);
    if (threadIdx.x == 0) { bst[0] = 0u; bst[1] = 0u; }
    __syncthreads();
    const XcdBarrier xbar = xcd_barrier_post((unsigned*)(p.ws + WS_CTL) + CW_BAR, bst);
    const int G = gridDim.x, bx = blockIdx.x;
#define RELOAD_WS() do { asm volatile("" : "+s"(p.ws)); p.ws = (unsigned char*)(GAS unsigned char*)p.ws; ws = p.ws; } while (0)
    unsigned char* ws = p.ws;
    PH(0) p0_prologue(p, lds);
    if (p.out == nullptr) grid.sync();
    xcd_barrier(xbar); RELOAD_WS();
    for (int half = 0; half < 2; ++half) {
        for (int l = 0; l < 2; ++l) {
            const int last = (l == 1), first = (l == 0);
#define wb (ws + WS_W + (size_t)l * W_LAYER)
#define MODl ((const float*)(ws + WS_MOD) + (size_t)l * 17 * 6144)
            PH(1) for (int rep = 0; rep < NREP(1); ++rep) norm_phase(p, lds, half, l, 0, first, 0);
            xcd_barrier(xbar); RELOAD_WS();
            PH(2) for (int rep = 0; rep < NREP(2); ++rep) {
                EpiIn E{ws, (const float*)(ws + WS_TAB), p.in[I_MCW] + l * 3 * 1024};
                if (!last) {
                    pg8::Sched1 S; S.o.init(MH, N_IN, G, bx); S.A = (const char*)(ws + WS_HN); S.B = (const char*)(wb + WO_IN); S.tsA = (size_t)256 * 1024 * 2; S.tsB = (size_t)256 * 1024 * 2; S.nt = 16;
                    pg8::gemm_phase(lds, 1024, 1024, S, E);
                } else {
                    pg8::SchedInLast S; S.o.init(MH, N_IN, G, bx, 1); S.A = (const char*)(ws + WS_HN); S.B = (const char*)(wb + WO_IN); S.tsA = (size_t)256 * 1024 * 2; S.tsB = (size_t)256 * 1024 * 2; S.nt = 16;
                    pg8::gemm_phase(lds, 1024, 1024, S, E);
                }
            }
            xcd_barrier(xbar); RELOAD_WS();
            qk_edge_phase(p, l);
            xcd_barrier(xbar); RELOAD_WS();
            PH(3) for (int rep = 0; rep < NREP(3); ++rep) {
                MixArgs A{ws, p.in[I_MCW] + l * 3 * 1024, p.in[I_SINK] + l * 8, p.in[I_RLOG] + l * 8, !last};
                mixer_phase(lds, A, (unsigned*)(ws + WS_CTL) + 64 * (half * 2 + l) + 256 * rep, rep ? PROBE_SEL : 7);
                if (rep + 1 < NREP(3)) xcd_barrier(xbar);
            }
            xcd_barrier(xbar); RELOAD_WS();
            PH(4) postmix_phase(p, l, last);
            xcd_barrier(xbar); RELOAD_WS();
            PH(5) for (int rep = 0; rep < NREP(5); ++rep) {
                pg8::Sched3 S; S.o.init(MH, 1024, G, bx, last); S.A = (const char*)(ws + WS_YCAT); S.B = (const char*)(wb + WO_BR); S.tsA = (size_t)256 * 2048 * 2; S.tsB = (size_t)256 * 2048 * 2;
                EpiBr E{(bf16_t*)(ws + WS_HN), (const bf16_t*)(ws + PO_G3)};
                pg8::gemm_phase(lds, 2048, 2048, S, E);
            }
            xcd_barrier(xbar); RELOAD_WS();
            PH(6) {
                pg8::Sched1 S; S.o.init(MH, 1024, G, bx, last); S.A = (const char*)(ws + WS_HN); S.B = (const char*)(wb + WO_OUT); S.tsA = (size_t)256 * 1024 * 2; S.tsB = (size_t)256 * 1024 * 2; S.nt = 16;
                EpiRes E{p.in[I_X], p.in[I_CTX], p.out, (float*)(ws + WS_XC), MODl + 2 * 1024, half, first, last};
                pg8::gemm_phase(lds, 1024, 1024, S, E);
            }
            xcd_barrier(xbar); RELOAD_WS();
            PH(7) for (int rep = 0; rep < NREP(7); ++rep) norm_phase(p, lds, half, l, 1, 0, last);
            xcd_barrier(xbar); RELOAD_WS();
            PH(8) for (int rep = 0; rep < NREP(8); ++rep) {
                pg8::Sched1 S; S.o.init(MH, 2 * FFN, G, bx, last); S.A = (const char*)(ws + WS_HN); S.B = (const char*)(wb + WO_UP); S.tsA = (size_t)256 * 1024 * 2; S.tsB = (size_t)256 * 1024 * 2; S.nt = 16;
                EpiUp E{(bf16_t*)(ws + WS_FB), (bf16_t*)(ws + WS_SA), (bf16_t*)(ws + WS_SB), p.in[I_FCW] + l * 3 * FFN, p.in[I_FCB] + l * FFN};
                pg8::gemm_phase(lds, 1024, 1024, S, E);
            }
            xcd_barrier(xbar); RELOAD_WS();
            PH(9) edge_phase(p, l, last);
            xcd_barrier(xbar); RELOAD_WS();
            PH(10) {
                pg8::Sched1 S; S.o.init(MH, 1024, G, bx, last); S.A = (const char*)(ws + WS_FB); S.B = (const char*)(wb + WO_DN); S.tsA = (size_t)256 * FFN * 2; S.tsB = (size_t)256 * FFN * 2; S.nt = FFN / 64;
                EpiRes E{p.in[I_X], p.in[I_CTX], p.out, (float*)(ws + WS_XC), MODl + 5 * 1024, half, 0, last};
                pg8::gemm_phase(lds, FFN, FFN, S, E);
            }
            xcd_barrier(xbar); RELOAD_WS();
        }
        PH(11) final_norm_phase(p, half);
    }
}

extern "C" void kernel_launch(void* const* d_in, const int* in_sizes, int n_in, void* d_out, int out_size, void* d_ws, size_t ws_size, hipStream_t stream) {
    static int grid = 0;
    if (grid == 0) {
        int dev = 0, cus = 0, per_cu = 0;
        (void)hipGetDevice(&dev);
        (void)hipDeviceGetAttribute(&cus, hipDeviceAttributeMultiprocessorCount, dev);
        (void)hipFuncSetAttribute((const void*)mk_fwd, hipFuncAttributeMaxDynamicSharedMemorySize, LDS_BYTES);
        (void)hipOccupancyMaxActiveBlocksPerMultiprocessor(&per_cu, (const void*)mk_fwd, 512, LDS_BYTES);
        if (per_cu < 1) per_cu = 1;
        grid = cus * per_cu;
        if (ws_size < WS_SQ + 5 * MiB) { fprintf(stderr, "kernel_launch: workspace too small (%zu < %zu)\n", ws_size, (size_t)PO_END); grid = -1; }
    }
    if (grid < 0) return;
    (void)hipMemsetAsync((char*)d_ws + WS_CTL, 0, 65536, stream);
    Params p{};
    for (int i = 0; i < 24; ++i) p.in[i] = (const float*)d_in[i];
    p.out = (float*)d_out; p.ws = (unsigned char*)d_ws;
    void* args[] = {&p};
    hipError_t e = hipLaunchCooperativeKernel((void*)mk_fwd, dim3(grid), dim3(512), args, LDS_BYTES, stream);
    if (e != hipSuccess) fprintf(stderr, "cooperative launch failed: %s (grid %d)\n", hipGetErrorString(e), grid);
}
```

```cpp
#include <hip/hip_runtime.h>
#include <hip/hip_cooperative_groups.h>
#include <cstdio>
#include <cstdint>
namespace cg = cooperative_groups;

#define DI __device__ __forceinline__
#define LAS __attribute__((address_space(3)))
#define GAS __attribute__((address_space(1)))
typedef unsigned short bf16_t;
typedef short bf16x8 __attribute__((ext_vector_type(8)));
typedef short s16x4 __attribute__((ext_vector_type(4)));
typedef float f32x4 __attribute__((ext_vector_type(4)));
typedef unsigned u32x4 __attribute__((ext_vector_type(4)));
typedef unsigned u32x2 __attribute__((ext_vector_type(2)));

constexpr int D = 1024, NBATCH = 16, SEQ = 4096, CTX = 256, PT = CTX + SEQ  ;
constexpr int HB = 8  , MH = HB * PT  , TPB = PT / 256  ;
constexpr int N_IN = 8960, FFN = 2816, IN_COLS = 8976;
constexpr size_t MiB = 1u << 20;
constexpr size_t WS_CTL = 0, WS_MOD = 1 * MiB, WS_TAB = 2 * MiB, WS_W = 5 * MiB, W_LAYER = 41 * MiB;
constexpr size_t WO_IN = 0, WO_BR = 18 * MiB, WO_OUT = 22 * MiB, WO_UP = 24 * MiB, WO_DN = 35 * MiB;
constexpr size_t WS_XC = 87 * MiB, WS_HN = 103 * MiB, WS_YCAT = 171 * MiB, WS_PROJ = 307 * MiB;
static_assert(WO_DN + (size_t)1024 * 2816 * 2 <= W_LAYER && WS_W + 2 * W_LAYER <= WS_XC, "weight map");
constexpr size_t SZ512 = (size_t)MH * 512 * 2;
constexpr size_t PO_MQ = WS_PROJ, PO_MK = PO_MQ + SZ512, PO_MV = PO_MK + SZ512, PO_MO = PO_MV + SZ512, PO_AQ = PO_MO + SZ512;
constexpr size_t PO_AK = PO_AQ + SZ512, PO_AV = PO_AK + SZ512 / 4, PO_RQ = PO_AV + SZ512 / 4, PO_RK = PO_RQ + SZ512, PO_RV = PO_RK + SZ512;
constexpr size_t PO_RG = PO_RV + 2 * SZ512, PO_G3 = PO_RG + 2 * SZ512, PO_MG = PO_G3 + 6 * SZ512, PO_END = PO_MG + (size_t)MH * 16 * 4;
constexpr size_t PO_MQC = PO_END, PO_MKC = PO_MQC + SZ512, WS_END = PO_MKC + SZ512;
static_assert(WS_END <= 1024 * MiB, "ws size");
constexpr size_t WS_HMB = WS_END, WS_HRB = PO_MQ, WS_END2 = WS_HMB + SZ512;
static_assert(WS_END2 <= 1024 * MiB && PO_MK == PO_MQ + SZ512, "ws size");
constexpr size_t WS_SQ = WS_HMB + SZ512;
static_assert(WS_SQ + (size_t)(MH / 64) * 4 * 1024 * 2 <= 1024 * MiB, "ws size");
constexpr size_t WS_FA = WS_PROJ, WS_FB = WS_FA + (size_t)MH * FFN * 2;
constexpr size_t WS_SA = WS_FA, WS_SB = WS_FA + 16 * MiB;
static_assert((size_t)(MH / 64) * 4 * FFN * 2 <= 16 * MiB && WS_SB + (size_t)(MH / 64) * 2 * FFN * 2 <= WS_FB, "side buffers");
static_assert(PO_END <= 1000 * MiB && WS_FB + (size_t)MH * FFN * 2 <= PO_G3, "ws map");
constexpr int TAB_COSR = 0, TAB_SINR = PT * 64, TAB_COSA = 2 * PT * 64, TAB_SINA = 2 * PT * 64 + 1024;

constexpr int LDS_BYTES = 147456;
#ifndef PH_MASK
#define PH_MASK 0xFFFF
#endif
#define PH(k) if constexpr ((PH_MASK >> (k)) & 1)
#ifndef DUP_MASK
#define DUP_MASK 0
#endif
#define NREP(k) (1 + ((DUP_MASK >> (k)) & 1))
#ifndef PROBE_SEL
#define PROBE_SEL 7
#endif

DI int lv(int x) { asm volatile("" : "+v"(x)); return x; }
DI int ls(int x) { asm volatile("" : "+s"(x)); return x; }
DI float ror1(float v) { return __builtin_bit_cast(float, __builtin_amdgcn_update_dpp(0, __builtin_bit_cast(int, v), 0x121, 0xF, 0xF, false)); }
DI float ror15(float v) { return __builtin_bit_cast(float, __builtin_amdgcn_update_dpp(0, __builtin_bit_cast(int, v), 0x12F, 0xF, 0xF, false)); }
DI unsigned cvt_pk_bf16(float lo, float hi) { unsigned r; asm volatile("v_cvt_pk_bf16_f32 %0, %1, %2" : "=v"(r) : "v"(lo), "v"(hi)); return r; }
DI float bf2f(unsigned short b) { return __uint_as_float(((unsigned)b) << 16); }
DI float bflo(unsigned w) { return __uint_as_float(w << 16); }
DI float bfhi(unsigned w) { return __uint_as_float(w & 0xffff0000u); }
DI float sigmoidf_(float x) { return __builtin_amdgcn_rcpf(1.f + __expf(-x)); }
DI float siluf_(float x) { return x * sigmoidf_(x); }
DI float logsigmoidf_(float x) { return fminf(x, 0.f) - __logf(1.f + __expf(-fabsf(x))); }
DI u32x2 pack4(f32x4 v) { u32x2 w; w.x = cvt_pk_bf16(v[0], v[1]); w.y = cvt_pk_bf16(v[2], v[3]); return w; }
DI f32x4 unpack4(u32x2 w) { return (f32x4){bflo(w.x), bfhi(w.x), bflo(w.y), bfhi(w.y)}; }

namespace pg8 {
constexpr int BM = 256, BK = 64, HALF = 128, HTB = HALF * BK * 2, STAGE_BYTES = 8 * HTB, NXCD = 8, WGM = 4;
__host__ __device__ __forceinline__ int lds_byte(int r, int c) { const int st = (r >> 4) * 2 + (c >> 5), rr = r & 15, cc = c & 31, ob = rr * 64 + cc * 2; return st * 1024 + (ob ^ (((ob >> 9) & 1) << 5)); }
__host__ __device__ __forceinline__ void stage_rc(int b, int& R, int& C) { const int st = b / 1024, sb = b % 1024, swz = sb ^ (((sb >> 9) & 1) << 5); R = (st >> 1) * 16 + swz / 64; C = (st & 1) * 32 + (swz % 64) / 2; }
__host__ __device__ __forceinline__ int perm32(int rho) { const int n = rho >> 4, i = rho & 15; return 8 * (i >> 2) + 4 * n + (i & 3); }
struct Unit { int pm, pn, br; };
struct StaticOrder {
    int nM, nN, nwg, G, c, lat;
    DI void init(int M, int N, int G_, int c_, int lat_ = 0) { lat = lat_; nM = lat_ ? HB * 16 : M / BM; nN = N / BM; nwg = nM * nN; G = G_; c = c_; }
    DI bool next(int i, Unit& u) const {
        const long L = (long)i * G + c; if (L >= nwg) return false;
        int wgid = (int)L; { const int q = nwg / NXCD, r = nwg % NXCD, xcd = wgid % NXCD, off = wgid / NXCD; wgid = (xcd < r ? xcd * (q + 1) : r * (q + 1) + (xcd - r) * q) + off; }
        const int nig = WGM * nN, gid = wgid / nig, fm = gid * WGM, gsz = (nM - fm) < WGM ? (nM - fm) : WGM;
        u.pm = fm + ((wgid % nig) % gsz); u.pn = (wgid % nig) / gsz; u.br = 0; if (lat) u.pm = (u.pm >> 4) * TPB + 1 + (u.pm & 15); return true;
    }
};
struct Sched1 {
    StaticOrder o; const char* A; const char* B; size_t tsA, tsB; int nt;
    DI bool next(int i, Unit& u) const { return o.next(i, u); }
    DI void locate(const Unit& u, const char*& a, const char*& b, int& n) const { a = A + (size_t)u.pm * tsA; b = B + (size_t)u.pn * tsB; n = nt; }
};
struct SchedInLast {
    StaticOrder o; const char* A; const char* B; size_t tsA, tsB; int nt;
    DI bool next(int i, Unit& u) const {
        const long L = (long)i * o.G + o.c;
        if (L < o.nwg) return o.next(i, u);
        const int e = (int)(L - o.nwg); if (e >= HB * 11) return false;
        const int bl = e / 11, k = e - bl * 11;
        u.pm = bl * TPB; u.pn = k < 4 ? 2 + k : (k == 4 ? 10 : 8 + k); u.br = 0; return true;
    }
    DI void locate(const Unit& u, const char*& a, const char*& b, int& n) const { a = A + (size_t)u.pm * tsA; b = B + (size_t)u.pn * tsB; n = nt; }
};
struct Sched3 {
    StaticOrder o; const char* A; const char* B; size_t tsA, tsB;
    DI bool next(int i, Unit& u) const { const int j = i / 3; if (!o.next(j, u)) return false; u.br = i - 3 * j; return true; }
    DI void locate(const Unit& u, const char*& a, const char*& b, int& n) const {
        const int koff = u.br == 0 ? 0 : (u.br == 1 ? 512 : 1024);
        a = A + (size_t)u.pm * tsA + koff * 2; b = B + (size_t)u.pn * tsB + koff * 2; n = u.br == 2 ? 16 : 8; }
};

template <class Epi, class Sched>
DI void gemm_phase(LAS unsigned char* lds, int lda, int ldb, const Sched& S, const Epi& E) {
    const int tid = lv(threadIdx.x), wid = __builtin_amdgcn_readfirstlane(tid >> 6), lane = tid & 63, wr = wid >> 2, wc = wid & 3, fr = lane & 15, fq = lane >> 4;
    unsigned voffA[2], voffB[2];
#pragma unroll
    for (int i = 0; i < 2; ++i) { int R, C; stage_rc(tid * 16 + i * 8192, R, C); const int Rb = Epi::PERM ? ((R & ~31) + perm32(R & 31)) : R; voffA[i] = (unsigned)(R * lda + C) * 2u; voffB[i] = (unsigned)(Rb * ldb + C) * 2u; }
    const size_t kstep = (size_t)(BK * 2);
    const size_t hsA = (size_t)HALF * lda * 2, hsB = (size_t)HALF * ldb * 2;
    const unsigned ldsw = (unsigned)wid * 1024u;
    const int aoff = lds_byte(wr * 64 + fr, fq * 8), boff = lds_byte(wc * 32 + fr, fq * 8);
#define PG8_SA(b, h) (((b) * 2 + (h)) * HTB)
#define PG8_SB(b, h) ((4 + (b) * 2 + (h)) * HTB)
#define PG8_STAGE(bufoff, gbase, voff) do { _Pragma("unroll") for (int _i = 0; _i < 2; ++_i) \
        __builtin_amdgcn_global_load_lds((const unsigned*)((const char*)(gbase) + (voff)[_i]), (LAS unsigned*)(lds + (bufoff) + ldsw + _i * 8192), 16, 0, 0); } while (0)
#define PG8_LDA(dst, b, h) do { _Pragma("unroll") for (int m = 0; m < 4; ++m) _Pragma("unroll") for (int k = 0; k < 2; ++k) dst[m][k] = *(const LAS bf16x8*)(lds + PG8_SA(b, h) + aoff + m * 2048 + k * 1024); } while (0)
#define PG8_LDB(dst, b, h) do { _Pragma("unroll") for (int n = 0; n < 2; ++n) _Pragma("unroll") for (int k = 0; k < 2; ++k) dst[n][k] = *(const LAS bf16x8*)(lds + PG8_SB(b, h) + boff + n * 2048 + k * 1024); } while (0)
#define PG8_MMA(ai, bj, At, Bt) do { __builtin_amdgcn_s_setprio(1); _Pragma("unroll") for (int m = 0; m < 4; ++m) _Pragma("unroll") for (int n = 0; n < 2; ++n) _Pragma("unroll") for (int k = 0; k < 2; ++k) \
        acc[ai][bj][m][n] = __builtin_amdgcn_mfma_f32_16x16x32_bf16(Bt[n][k], At[m][k], acc[ai][bj][m][n], 0, 0, 0); __builtin_amdgcn_s_setprio(0); } while (0)
#define PG8_WAIT_V(n) asm volatile("s_waitcnt vmcnt(" #n ")" ::: "memory")
#define PG8_WAIT_L(n) asm volatile("s_waitcnt lgkmcnt(" #n ")" ::: "memory")
#define PG8_BAR __builtin_amdgcn_s_barrier()
#define PG8_SCHED __builtin_amdgcn_sched_barrier(0)
    Unit cur, nxt; int ui = 0;
    if (!S.next(0, cur)) return;
    f32x4 acc[2][2][4][2];
#pragma unroll
    for (int a = 0; a < 2; ++a)
#pragma unroll
        for (int b = 0; b < 2; ++b)
#pragma unroll
            for (int m = 0; m < 4; ++m)
#pragma unroll
                for (int n = 0; n < 2; ++n) acc[a][b][m][n] = (f32x4){0.f, 0.f, 0.f, 0.f};
    bf16x8 At[4][2], B0[2][2], B1[2][2];
    const char* cA; const char* cB; int nt; S.locate(cur, cA, cB, nt);
    PG8_STAGE(PG8_SB(0, 0), cB, voffB); PG8_STAGE(PG8_SB(0, 1), cB + hsB, voffB); PG8_STAGE(PG8_SA(0, 0), cA, voffA); PG8_STAGE(PG8_SA(0, 1), cA + hsA, voffA);
    if (wr == 1) PG8_BAR;
    PG8_WAIT_V(2); PG8_BAR;
    PG8_STAGE(PG8_SB(1, 0), cB + kstep, voffB); PG8_STAGE(PG8_SA(1, 0), cA + kstep, voffA); PG8_STAGE(PG8_SB(1, 1), cB + hsB + kstep, voffB);
    PG8_WAIT_V(6); PG8_BAR;
    for (;;) {
        const bool has_next = S.next(ui + 1, nxt);
        const char* nA = cA; const char* nB = cB; int nnt = nt;
        if (has_next) S.locate(nxt, nA, nB, nnt);
        for (int t = 0; t < nt; t += 2) {
            const bool last = (t == nt - 2);
            const char* a1 = cA + (size_t)(t + 1) * kstep;
            const char* a2 = last ? nA : cA + (size_t)(t + 2) * kstep; const char* b2 = last ? nB : cB + (size_t)(t + 2) * kstep;
            const char* a3 = a2 + kstep; const char* b3 = b2 + kstep;
            PG8_LDB(B0, 0, 0); PG8_LDB(B1, 0, 1); PG8_SCHED; PG8_LDA(At, 0, 0); PG8_STAGE(PG8_SA(1, 1), a1 + hsA, voffA);
            PG8_WAIT_V(8); PG8_WAIT_L(0); PG8_BAR; PG8_MMA(0, 0, At, B0); PG8_MMA(0, 1, At, B1); PG8_BAR; PG8_SCHED;
            PG8_LDA(At, 0, 1); PG8_STAGE(PG8_SB(0, 0), b2, voffB); PG8_STAGE(PG8_SB(0, 1), b2 + hsB, voffB); PG8_STAGE(PG8_SA(0, 0), a2, voffA);
            PG8_WAIT_V(8); PG8_WAIT_L(0); PG8_BAR; PG8_MMA(1, 0, At, B0); PG8_MMA(1, 1, At, B1); PG8_BAR; PG8_SCHED;
            PG8_LDB(B0, 1, 0); PG8_LDB(B1, 1, 1); PG8_SCHED; PG8_LDA(At, 1, 0); PG8_STAGE(PG8_SA(0, 1), a2 + hsA, voffA);
            PG8_WAIT_V(8); PG8_WAIT_L(0); PG8_BAR; PG8_MMA(0, 0, At, B0); PG8_MMA(0, 1, At, B1); PG8_BAR; PG8_SCHED;
            PG8_LDA(At, 1, 1); PG8_STAGE(PG8_SB(1, 0), b3, voffB); PG8_STAGE(PG8_SB(1, 1), b3 + hsB, voffB); PG8_STAGE(PG8_SA(1, 0), a3, voffA);
            PG8_WAIT_V(8); PG8_WAIT_L(0); PG8_BAR; PG8_MMA(1, 0, At, B0); PG8_MMA(1, 1, At, B1); PG8_BAR; PG8_SCHED;
        }
        if (wr == 0) PG8_BAR;
        E(acc, cur, wr, wc, fr, fq);
        if (!has_next) break;
#pragma unroll
        for (int a = 0; a < 2; ++a)
#pragma unroll
            for (int b = 0; b < 2; ++b)
#pragma unroll
                for (int m = 0; m < 4; ++m)
#pragma unroll
                    for (int n = 0; n < 2; ++n) acc[a][b][m][n] = (f32x4){0.f, 0.f, 0.f, 0.f};
        cur = nxt; cA = nA; cB = nB; nt = nnt; ++ui;
        if (wr == 1) PG8_BAR;
    }
    PG8_WAIT_V(0);
    PG8_BAR;
#undef PG8_SA
#undef PG8_SB
#undef PG8_STAGE
#undef PG8_LDA
#undef PG8_LDB
#undef PG8_MMA
#undef PG8_WAIT_V
#undef PG8_WAIT_L
#undef PG8_BAR
#undef PG8_SCHED
}
}
using pg8::Unit;

typedef f32x4 Acc[2][2][4][2];

struct EpiIn {
    static constexpr bool PERM = true;
    unsigned char* ws; const float* tab; const float* mcw;
    DI void conv_tile(const Acc& acc, const Unit& u, int wr, int wc, int fr, int fq) const {
        const int which = u.pn >> 1;
        bf16_t* dst = (bf16_t*)(ws + (which ? PO_MKC : PO_MQC)); bf16_t* SQ = (bf16_t*)(ws + WS_SQ);
        const float sc = which ? 0.08838834764831845f : 1.f;
#pragma unroll
        for (int bj = 0; bj < 2; ++bj) {
            const int c0 = (u.pn & 1) * 256 + bj * 128 + wc * 32 + fq * 8;
            f32x4 w0[2], w1[2], w2[2];
#pragma unroll
            for (int n = 0; n < 2; ++n) { const float* cw = mcw + which * 512 + c0 + 4 * n; w0[n] = *(const GAS f32x4*)cw; w1[n] = *(const GAS f32x4*)(cw + 1024); w2[n] = *(const GAS f32x4*)(cw + 2048); }
#pragma unroll
            for (int ai = 0; ai < 2; ++ai) {
                const size_t rb = (size_t)u.pm * 256 + ai * 128 + wr * 64; const size_t blk = rb >> 6;
                f32x4 rprev[2], lcur[2];
#pragma unroll
                for (int n = 0; n < 2; ++n)
#pragma unroll
                    for (int e = 0; e < 4; ++e) { rprev[n][e] = 0.f; lcur[n][e] = ror15(acc[ai][bj][0][n][e]); }
#pragma unroll
                for (int m = 0; m < 4; ++m) {
                    u32x2 pk[2];
#pragma unroll
                    for (int n = 0; n < 2; ++n) {
                        const f32x4 a = acc[ai][bj][m][n];
                        f32x4 rcur, lnext, o;
#pragma unroll
                        for (int e = 0; e < 4; ++e) { rcur[e] = ror1(a[e]); lnext[e] = m < 3 ? ror15(acc[ai][bj][m < 3 ? m + 1 : 3][n][e]) : 0.f; }
#pragma unroll
                        for (int e = 0; e < 4; ++e) { const float pv = fr > 0 ? rcur[e] : rprev[n][e], nx = fr < 15 ? lcur[n][e] : lnext[e];
                            o[e] = siluf_(w0[n][e] * pv + w1[n][e] * a[e] + w2[n][e] * nx) * sc; }
                        pk[n] = pack4(o); rprev[n] = rcur; lcur[n] = lnext;
                    }
                    const bool edge = (m == 0 && fr == 0) || (m == 3 && fr == 15);
                    if (!edge) *(GAS u32x4*)(dst + (rb + 16 * m + fr) * 512 + c0) = (u32x4){pk[0].x, pk[0].y, pk[1].x, pk[1].y};
                    if ((m == 0 && fr < 2) || (m == 3 && fr >= 14)) {
                        const int slot = m == 0 ? fr : fr - 12;
                        const u32x2 a0 = pack4(acc[ai][bj][m][0]), a1 = pack4(acc[ai][bj][m][1]);
                        *(GAS u32x4*)(SQ + (blk * 4 + slot) * 1024 + which * 512 + c0) = (u32x4){a0.x, a0.y, a1.x, a1.y};
                    }
                }
            }
        }
    }
    DI void operator()(const Acc& acc, const Unit& u, int wr, int wc, int fr, int fq) const {
        fr = lv(fr); fq = lv(fq); wr = ls(wr); wc = ls(wc);
        const int pn = u.pn, jt = u.pm % TPB; const bool is_ctx = (jt == 0);
        if (pn < 4) { conv_tile(acc, u, wr, wc, fr, fq); return; }
#pragma unroll
        for (int bj = 0; bj < 2; ++bj) {
            size_t off; int ld, col, act; float scale = 1.f;
            if (pn < 2) { off = PO_MQ; ld = 512; col = pn * 256; act = 0; }
            else if (pn < 4) { off = PO_MK; ld = 512; col = (pn - 2) * 256; act = 0; }
            else if (pn < 6) { off = PO_MV; ld = 512; col = (pn - 4) * 256; act = 0; }
            else if (pn < 8) { off = PO_MO; ld = 512; col = (pn - 6) * 256; act = 1; }
            else if (pn < 10) { off = PO_AQ; ld = 512; col = (pn - 8) * 256; act = 3; scale = 0.125f * 1.4426950408889634f; }
            else if (pn == 10) { if (bj == 0) { off = PO_AK; ld = 128; col = -128 * bj; act = 3; } else { off = PO_AV; ld = 128; col = -128; act = 0; } }
            else if (pn < 13) { off = PO_RQ; ld = 512; col = (pn - 11) * 256; act = 4; }
            else if (pn < 15) { off = PO_RK; ld = 512; col = (pn - 13) * 256; act = 4; scale = 0.08838834764831845f; }
            else if (pn < 19) { off = PO_RV; ld = 1024; col = (pn - 15) * 256; act = 0; }
            else if (pn < 23) { off = PO_RG; ld = 1024; col = (pn - 19) * 256; act = 2; }
            else { off = PO_G3; ld = 3072; col = (pn - 23) * 256; act = 1; }
            bf16_t* dst = (bf16_t*)(ws + off);
            const int c0 = col + bj * 128 + wc * 32 + fq * 8;
#pragma unroll
            for (int ai = 0; ai < 2; ++ai)
#pragma unroll
                for (int m = 0; m < 4; ++m) {
                    const int rit = ai * 128 + wr * 64 + m * 16 + fr;
                    const size_t r = (size_t)u.pm * 256 + rit;
                    f32x4 v0 = acc[ai][bj][m][0], v1 = acc[ai][bj][m][1];
                    if (act == 1) {
#pragma unroll
                        for (int e = 0; e < 4; ++e) { v0[e] = sigmoidf_(v0[e]); v1[e] = sigmoidf_(v1[e]); }
                    } else if (act == 2) {
#pragma unroll
                        for (int e = 0; e < 4; ++e) { v0[e] = siluf_(v0[e]); v1[e] = siluf_(v1[e]); }
                    } else if (act == 3) {
                        if (!is_ctx) {
                            const int t = (jt - 1) * 256 + rit; const int posv = (wc & 1) ? (t & 63) : (t >> 6);
                            const f32x4 cs = *(const GAS f32x4*)(tab + TAB_COSA + posv * 16 + fq * 4), sn = *(const GAS f32x4*)(tab + TAB_SINA + posv * 16 + fq * 4);
                            const f32x4 a = v0 * cs - v1 * sn, b = v0 * sn + v1 * cs; v0 = a; v1 = b;
                        }
                        v0 = v0 * scale; v1 = v1 * scale;
                    } else if (act == 4) {
                        const int p = jt * 256 + rit;
                        const f32x4 cs = *(const GAS f32x4*)(tab + TAB_COSR + p * 64 + wc * 16 + fq * 4), sn = *(const GAS f32x4*)(tab + TAB_SINR + p * 64 + wc * 16 + fq * 4);
                        const f32x4 a = v0 * cs - v1 * sn, b = v0 * sn + v1 * cs; v0 = a * scale; v1 = b * scale;
                    }
                    bf16_t* rp = dst + r * ld + c0;
                    { const u32x2 p0 = pack4(v0), p1 = pack4(v1); *(GAS u32x4*)rp = (u32x4){p0.x, p0.y, p1.x, p1.y}; }
                }
        }
    }
};
struct EpiBr {
    static constexpr bool PERM = true;
    bf16_t* Z; const bf16_t* G3;
    DI void operator()(const Acc& acc, const Unit& u, int wr, int wc, int fr, int fq) const {
        fr = lv(fr); fq = lv(fq); wr = ls(wr); wc = ls(wc);
        const int br = u.br;
#pragma unroll
        for (int ai = 0; ai < 2; ++ai) {
            u32x4 gw[4][2], zo[4][2];
#pragma unroll
            for (int m = 0; m < 4; ++m) {
                const size_t r = (size_t)u.pm * 256 + ai * 128 + wr * 64 + m * 16 + fr;
#pragma unroll
                for (int bj = 0; bj < 2; ++bj) {
                    const int c = u.pn * 256 + bj * 128 + wc * 32 + fq * 8;
                    gw[m][bj] = *(const GAS u32x4*)(G3 + r * 3072 + br * 1024 + c);
                    if (br > 0) zo[m][bj] = *(const GAS u32x4*)(Z + r * 1024 + c);
                }
            }
            __builtin_amdgcn_sched_barrier(0);
#pragma unroll
            for (int m = 0; m < 4; ++m) {
                const size_t r = (size_t)u.pm * 256 + ai * 128 + wr * 64 + m * 16 + fr;
#pragma unroll
                for (int bj = 0; bj < 2; ++bj) {
                    const int c = u.pn * 256 + bj * 128 + wc * 32 + fq * 8;
                    const u32x4 g4 = gw[m][bj];
                    f32x4 z0 = unpack4((u32x2){g4.x, g4.y}) * acc[ai][bj][m][0], z1 = unpack4((u32x2){g4.z, g4.w}) * acc[ai][bj][m][1];
                    if (br > 0) { const u32x4 z4 = zo[m][bj]; z0 = z0 + unpack4((u32x2){z4.x, z4.y}); z1 = z1 + unpack4((u32x2){z4.z, z4.w}); }
                    const u32x2 p0 = pack4(z0), p1 = pack4(z1);
                    *(GAS u32x4*)(Z + r * 1024 + c) = (u32x4){p0.x, p0.y, p1.x, p1.y};
                }
            }
            __builtin_amdgcn_sched_barrier(0);
        }
    }
};
struct EpiRes {
    static constexpr bool PERM = true;
    const float* x_in; const float* ctx_in; float* out; float* xc; const float* gate; int half, first, skip_ctx;
    DI void operator()(const Acc& acc, const Unit& u, int wr, int wc, int fr, int fq) const {
        fr = lv(fr); fq = lv(fq); wr = ls(wr); wc = ls(wc);
        const int bl = u.pm / TPB, jt = u.pm - bl * TPB, b = half * HB + bl; const bool is_ctx = (jt == 0);
        if (is_ctx && skip_ctx) return;
        const float* gr = gate + (size_t)(is_ctx ? 16 : b) * 6144;
        f32x4 g[2][2];
#pragma unroll
        for (int bj = 0; bj < 2; ++bj)
#pragma unroll
            for (int n = 0; n < 2; ++n) g[bj][n] = *(const GAS f32x4*)(gr + u.pn * 256 + bj * 128 + wc * 32 + fq * 8 + n * 4);
        float* const dbase = is_ctx ? xc : out;
        const float* const bbase = first ? (is_ctx ? ctx_in : x_in) : (const float*)dbase;
        const size_t rbase0 = is_ctx ? (size_t)b * CTX : (size_t)b * SEQ + (jt - 1) * 256;
#pragma unroll
        for (int ai = 0; ai < 2; ++ai)
#pragma unroll
        for (int mh = 0; mh < 2; ++mh) {
            f32x4 xs[2][2][2];
#pragma unroll
            for (int m2 = 0; m2 < 2; ++m2) {
                const int rit = ai * 128 + wr * 64 + (mh * 2 + m2) * 16 + fr;
                const float* bp = bbase + (rbase0 + rit) * D;
#pragma unroll
                for (int bj = 0; bj < 2; ++bj)
#pragma unroll
                    for (int n = 0; n < 2; ++n) xs[m2][bj][n] = *(const GAS f32x4*)(bp + u.pn * 256 + bj * 128 + wc * 32 + fq * 8 + n * 4);
            }
            __builtin_amdgcn_sched_barrier(0);
#pragma unroll
            for (int m2 = 0; m2 < 2; ++m2) {
                const int m = mh * 2 + m2;
                const int rit = ai * 128 + wr * 64 + m * 16 + fr;
                float* dp = dbase + (rbase0 + rit) * D;
#pragma unroll
                for (int bj = 0; bj < 2; ++bj)
#pragma unroll
                    for (int n = 0; n < 2; ++n) *(GAS f32x4*)(dp + u.pn * 256 + bj * 128 + wc * 32 + fq * 8 + n * 4) = xs[m2][bj][n] + g[bj][n] * acc[ai][bj][m][n];
            }
            __builtin_amdgcn_sched_barrier(0);
        }
    }
};
struct EpiUp {
    static constexpr bool PERM = true;
    bf16_t* U; bf16_t* SA; bf16_t* SB; const float* cw; const float* cb;
    DI void operator()(const Acc& acc, const Unit& u, int wr, int wc, int fr, int fq) const {
        fr = lv(fr); fq = lv(fq); wr = ls(wr); wc = ls(wc);
        const int lane = fq * 16 + fr, c0 = u.pn * 128 + wc * 32 + fq * 8;
        f32x4 w0[2], w1[2], w2[2], bs[2];
#pragma unroll
        for (int n = 0; n < 2; ++n) { w0[n] = *(const GAS f32x4*)(cw + c0 + 4 * n); w1[n] = *(const GAS f32x4*)(cw + FFN + c0 + 4 * n); w2[n] = *(const GAS f32x4*)(cw + 2 * FFN + c0 + 4 * n); bs[n] = *(const GAS f32x4*)(cb + c0 + 4 * n); }
#pragma unroll
        for (int ai = 0; ai < 2; ++ai) {
            const size_t rb = (size_t)u.pm * 256 + ai * 128 + wr * 64;
            const size_t blk = rb >> 6;
            f32x4 rprev[2], lcur[2];
#pragma unroll
            for (int n = 0; n < 2; ++n)
#pragma unroll
                for (int e = 0; e < 4; ++e) { rprev[n][e] = 0.f; lcur[n][e] = ror15(acc[ai][0][0][n][e]); }
#pragma unroll
            for (int m = 0; m < 4; ++m) {
                u32x2 pk[2];
#pragma unroll
                for (int n = 0; n < 2; ++n) {
                    const f32x4 a = acc[ai][0][m][n], b = acc[ai][1][m][n];
                    f32x4 rcur, lnext;
#pragma unroll
                    for (int e = 0; e < 4; ++e) { rcur[e] = ror1(a[e]); lnext[e] = m < 3 ? ror15(acc[ai][0][m < 3 ? m + 1 : 3][n][e]) : 0.f; }
                    f32x4 o;
#pragma unroll
                    for (int e = 0; e < 4; ++e) {
                        const float pv = fr > 0 ? rcur[e] : rprev[n][e], nx = fr < 15 ? lcur[n][e] : lnext[e];
                        o[e] = siluf_(w0[n][e] * pv + w1[n][e] * a[e] + w2[n][e] * nx + bs[n][e]) * b[e];
                    }
                    pk[n] = pack4(o);
                    rprev[n] = rcur; lcur[n] = lnext;
                }
                const bool edge = (m == 0 && fr == 0) || (m == 3 && fr == 15);
                if (!edge) *(GAS u32x4*)(U + (rb + 16 * m + fr) * FFN + c0) = (u32x4){pk[0].x, pk[0].y, pk[1].x, pk[1].y};
                if (m == 0 || m == 3) {
                    const int slot = m == 0 ? fr : fr - 12;
                    if (slot >= 0 && slot < 4 && (m == 0 ? fr < 2 : fr >= 14)) {
                        const u32x2 a0 = pack4(acc[ai][0][m][0]), a1 = pack4(acc[ai][0][m][1]);
                        *(GAS u32x4*)(SA + (blk * 4 + slot) * FFN + c0) = (u32x4){a0.x, a0.y, a1.x, a1.y};
                        if (edge) { const u32x2 b0 = pack4(acc[ai][1][m][0]), b1 = pack4(acc[ai][1][m][1]);
                            *(GAS u32x4*)(SB + (blk * 2 + (m == 3)) * FFN + c0) = (u32x4){b0.x, b0.y, b1.x, b1.y}; }
                    }
                }
            }
        }
    }
};
struct MixArgs { unsigned char* ws; const float* conv_w; const float* sink; const float* ret_logit; int need_ctx; };
DI bf16x8 ldfrag(const LAS unsigned char* p) { return *(const LAS bf16x8*)p; }
DI bf16x8 trfrag(const LAS unsigned char* p, int off2) {
    const s16x4 a = __builtin_amdgcn_ds_read_tr16_b64_v4i16((LAS s16x4*)p);
    const s16x4 b = __builtin_amdgcn_ds_read_tr16_b64_v4i16((LAS s16x4*)(p + off2));
    return (bf16x8){a[0], a[1], a[2], a[3], b[0], b[1], b[2], b[3]};
}
DI bf16x8 pack8(f32x4 a, f32x4 b) { u32x4 w; w.x = cvt_pk_bf16(a[0], a[1]); w.y = cvt_pk_bf16(a[2], a[3]); w.z = cvt_pk_bf16(b[0], b[1]); w.w = cvt_pk_bf16(b[2], b[3]); return __builtin_bit_cast(bf16x8, w); }
#define MFMA16(a, b, c) __builtin_amdgcn_mfma_f32_16x16x32_bf16(a, b, c, 0, 0, 0)

constexpr int LROW = 288, BROW = 272;

constexpr int L_QS = 0, L_KS = 17408, L_KWS = 34816, L_VS = 53248, L_CS = 71680, L_SC = 110848;
template <bool ML>
DI void linattn_unit(LAS unsigned char* lds, const MixArgs& A, int bl, int h, int vs, int dir) {
    const int tid = lv(threadIdx.x), wid = __builtin_amdgcn_readfirstlane(tid >> 6), lane = tid & 63, li = lane & 15, qq = lane >> 4;
    constexpr int NVT = ML ? 9 : 8, NX = ML ? 5 : 4;
    const GAS bf16_t* Qg = (const GAS bf16_t*)(A.ws + (ML ? PO_MQC : PO_RQ)) + h * 128;
    const GAS bf16_t* Kg = (const GAS bf16_t*)(A.ws + (ML ? PO_MKC : PO_RK)) + h * 128;
    const int ldv = ML ? 512 : 1024;
    const GAS bf16_t* Vg = (const GAS bf16_t*)(A.ws + (ML ? PO_MV : PO_RV)) + (ML ? h * 128 : h * 256 + vs * 128);
    GAS bf16_t* Og; int ldo;
    if (dir == 0) { Og = (GAS bf16_t*)(A.ws + WS_YCAT) + (ML ? h * 128 : 1024 + h * 256 + vs * 128); ldo = 2048; }
    else if (ML) { Og = (GAS bf16_t*)(A.ws + WS_HMB) + h * 128; ldo = 512; }
    else { Og = (GAS bf16_t*)(A.ws + WS_HRB) + h * 256 + vs * 128; ldo = 1024; }
    const GAS float* MGg = (const GAS float*)(A.ws + PO_MG);
    const size_t row0 = (size_t)bl * PT;
    LAS float* sbm = (LAS float*)(lds + L_SC) + wid * 384; LAS float* su = sbm + 64; LAS float* siw = sbm + 128; LAS float* sw = sbm + 192; LAS float* sem = sbm + 256;
    const int sgq = tid & 15;
    __syncthreads();
    if (ML) {
        if (tid < 64) { LAS unsigned* vp = (LAS unsigned*)(lds + L_VS + tid * LROW + 256); const unsigned zz = (unsigned)lv(0);
#pragma unroll
            for (int e = 0; e < 8; ++e) vp[e] = e == 0 ? (zz | 0x3F80u) : zz; }
    }
    {
        f32x4 cacc[NVT];
#pragma unroll
        for (int t = 0; t < NVT; ++t) cacc[t] = (f32x4){0.f, 0.f, 0.f, 0.f};
        for (int i = tid; i < NVT * 16 * (BROW / 4); i += 512) ((LAS unsigned*)(lds + L_CS))[i] = 0u;
        float m_run = 0.f;
        const float lg = ML ? 0.f : logsigmoidf_(A.ret_logit[dir * 4 + h]);
        u32x4 pq[2], pk[2], pvv[2]; float plf = lg, plii = 0.f;
#define LA_LOAD(CI) do { const int mc_ = dir == 0 ? (CI) : ((CI) < 4 ? 3 - (CI) : 71 - (CI)), p0_ = mc_ * 64; const size_t rb_ = row0 + p0_; \
            if (ML) { const GAS float* g_ = MGg + (rb_ + lane) * 16; plf = g_[(dir ? 12 : 4) + h]; plii = g_[(dir ? 8 : 0) + h]; } \
            _Pragma("unroll") for (int it_ = 0; it_ < 2; ++it_) { const int i_ = (tid + it_ * 512) >> 4; pq[it_] = *(const GAS u32x4*)(Qg + (rb_ + i_) * 512 + sgq * 8); pk[it_] = *(const GAS u32x4*)(Kg + (rb_ + i_) * 512 + sgq * 8); \
                pvv[it_] = *(const GAS u32x4*)(Vg + (rb_ + i_) * ldv + sgq * 8); } } while (0)
        LA_LOAD(0);
        for (int ci = 0; ci < 68; ++ci) {
            const int mc = dir == 0 ? ci : (ci < 4 ? 3 - ci : 71 - ci), p0 = mc * 64;
            const size_t rbase = row0 + p0;
            float decay;
            {
                float b, u, g, cml = 0.f, cm = 0.f;
                if (ML) {
                    const float lf = plf, lii = plii;
                    b = lf;
                    if (dir == 0) {
#pragma unroll
                        for (int o = 1; o < 64; o <<= 1) { const float t = __shfl_up(b, o); if (lane >= o) b += t; }
                    } else {
#pragma unroll
                        for (int o = 1; o < 64; o <<= 1) { const float t = __shfl_down(b, o); if (lane + o < 64) b += t; }
                    }
                    u = lii - b; cm = u;
                    if (dir == 0) {
#pragma unroll
                        for (int o = 1; o < 64; o <<= 1) { const float t = __shfl_up(cm, o); if (lane >= o) cm = fmaxf(cm, t); }
                    } else {
#pragma unroll
                        for (int o = 1; o < 64; o <<= 1) { const float t = __shfl_down(cm, o); if (lane + o < 64) cm = fmaxf(cm, t); }
                    }
                    g = __shfl(b, dir ? 0 : 63); cml = __shfl(cm, dir ? 0 : 63);
                } else {
                    b = (float)(dir ? 64 - lane : lane + 1) * lg; u = -b; g = 64.f * lg;
                }
                float bm, iw, w, em, m_new;
                if (ML) { const float mj = b + fmaxf(m_run, cm); iw = __expf(b + m_run - mj); m_new = g + fmaxf(m_run, cml); w = __expf(g + u - m_new); decay = __expf(g + m_run - m_new); em = __expf(-mj); bm = b - mj; }
                else { bm = b; iw = __expf(b); w = __expf(g + u); decay = __expf(g); em = 1.f; m_new = 0.f; }
                sbm[lane] = bm; su[lane] = u; siw[lane] = iw; sw[lane] = w; sem[lane] = em;
                m_run = m_new;
            }
#pragma unroll
            for (int it = 0; it < 2; ++it) {
                const int idx = tid + it * 512, i = idx >> 4, sg = sgq; const float wi = sw[i];
                const u32x4 ko = pk[it]; u32x4 kwo;
#pragma unroll
                for (int e = 0; e < 4; ++e) kwo[e] = cvt_pk_bf16(bflo(ko[e]) * wi, bfhi(ko[e]) * wi);
                *(LAS u32x4*)(lds + L_QS + i * BROW + sg * 16) = pq[it]; *(LAS u32x4*)(lds + L_KS + i * BROW + sg * 16) = ko; *(LAS u32x4*)(lds + L_KWS + i * LROW + sg * 16) = kwo;
                *(LAS u32x4*)(lds + L_VS + i * LROW + sg * 16) = pvv[it];
            }
            if (ci + 1 < 68) LA_LOAD(ci + 1);
            __syncthreads();
            {
                const int jt = wid & 3, dg = wid >> 2, j = 16 * jt + li;
                bf16x8 qf[4];
#pragma unroll
                for (int ks = 0; ks < 4; ++ks) qf[ks] = ldfrag(lds + L_QS + j * BROW + (32 * ks + 8 * qq) * 2);
                f32x4 s[4];
#pragma unroll
                for (int rt = 0; rt < 4; ++rt) { s[rt] = (f32x4){0.f, 0.f, 0.f, 0.f};
#pragma unroll
                    for (int ks = 0; ks < 4; ++ks) s[rt] = MFMA16(ldfrag(lds + L_KS + (16 * rt + li) * BROW + (32 * ks + 8 * qq) * 2), qf[ks], s[rt]); }
                const float bmj = sbm[j];
#pragma unroll
                for (int rt = 0; rt < 4; ++rt) { const f32x4 u4 = *(const LAS f32x4*)(su + 16 * rt + 4 * qq);
#pragma unroll
                    for (int e = 0; e < 4; ++e) { const int r = 16 * rt + 4 * qq + e; const bool ok = dir ? (r >= j) : (r <= j); s[rt][e] = ok ? s[rt][e] * __expf(bmj + u4[e]) : 0.f; } }
                bf16x8 pf[2];
                pf[0] = pack8(s[0], s[1]); pf[1] = pack8(s[2], s[3]);
                f32x4 o[NX];
                const float iw = siw[j];
#pragma unroll
                for (int x = 0; x < NX; ++x) {
                    const int dvt = x < 4 ? 4 * dg + x : 8;
                    f32x4 oo = (f32x4){0.f, 0.f, 0.f, 0.f}, itr = oo;
#pragma unroll
                    for (int kk = 0; kk < 2; ++kk) oo = MFMA16(trfrag(lds + L_VS + (32 * kk + 4 * qq + (li >> 2)) * LROW + (16 * dvt + 4 * (li & 3)) * 2, 16 * LROW), pf[kk], oo);
#pragma unroll
                    for (int ks = 0; ks < 4; ++ks) itr = MFMA16(ldfrag(lds + L_CS + (16 * dvt + li) * BROW + (32 * ks + 8 * qq) * 2), qf[ks], itr);
                    o[x] = oo + itr * iw;
                }
                if (ML) {
                    const float den = __shfl(o[NX - 1][0], li);
                    const float inv = __builtin_amdgcn_rcpf(fmaxf(fabsf(den), sem[j]));
#pragma unroll
                    for (int x = 0; x < 4; ++x) o[x] = o[x] * inv;
                }
                if (A.need_ctx || p0 >= CTX) {
#pragma unroll
                    for (int x = 0; x < 4; ++x) *(GAS u32x2*)(Og + (rbase + j) * ldo + 16 * (4 * dg + x) + 4 * qq) = pack4(o[x]);
                }
                bf16x8 kwf[2];
#pragma unroll
                for (int kk = 0; kk < 2; ++kk) kwf[kk] = trfrag(lds + L_KWS + (32 * kk + 4 * qq + (li >> 2)) * LROW + (16 * wid + 4 * (li & 3)) * 2, 16 * LROW);
#pragma unroll
                for (int t = 0; t < NVT; ++t) { cacc[t] = cacc[t] * decay;
#pragma unroll
                    for (int kk = 0; kk < 2; ++kk) cacc[t] = MFMA16(kwf[kk], trfrag(lds + L_VS + (32 * kk + 4 * qq + (li >> 2)) * LROW + (16 * t + 4 * (li & 3)) * 2, 16 * LROW), cacc[t]); }
            }
            __syncthreads();
#pragma unroll
            for (int t = 0; t < NVT; ++t) *(LAS u32x2*)(lds + L_CS + (16 * t + li) * BROW + (16 * wid + 4 * qq) * 2) = pack4(cacc[t]);
        }
        __syncthreads();
    }
#undef LA_LOAD
}

constexpr int A_KROW = 144, A_VROW = 160, A_KT = 0, A_VT = 64 * A_KROW, A_QT = A_VT + 64 * A_VROW;
DI void attn_unit(LAS unsigned char* lds, const MixArgs& A, int bl, int kvh, int qb, int hp, bool ctxq) {
    const int tid = lv(threadIdx.x), wid = __builtin_amdgcn_readfirstlane(tid >> 6), lane = tid & 63, li = lane & 15, qq = lane >> 4;
    const int gq = hp * 2 + (wid >> 2), q32 = wid & 3, head = kvh * 4 + gq;
    const size_t row0 = (size_t)bl * PT;
    const size_t qrow0 = row0 + (ctxq ? 0 : CTX) + qb * 128 + q32 * 32;
    const GAS bf16_t* AQ = (const GAS bf16_t*)(A.ws + PO_AQ); const GAS bf16_t* AK = (const GAS bf16_t*)(A.ws + PO_AK); const GAS bf16_t* AV = (const GAS bf16_t*)(A.ws + PO_AV);
    GAS bf16_t* Og = (GAS bf16_t*)(A.ws + WS_YCAT) + 512 + head * 64;
    const LAS unsigned char* qt = lds + A_QT + wid * 32 * A_KROW;
    __syncthreads();
#pragma unroll
    for (int it = 0; it < 4; ++it) { const int idx = lane + it * 64, row = idx >> 3, sg = idx & 7;
        *(LAS u32x4*)(lds + A_QT + (wid * 32 + row) * A_KROW + sg * 16) = *(const GAS u32x4*)(AQ + (qrow0 + row) * 512 + head * 64 + sg * 8); }
    const float sink = A.sink[head] * 1.4426950408889634f;
    float mrun[2], lsum[2]; f32x4 o[4][2];
#pragma unroll
    for (int jt = 0; jt < 2; ++jt) { mrun[jt] = sink; lsum[jt] = qq == 0 ? 1.f : 0.f;
#pragma unroll
        for (int d = 0; d < 4; ++d) o[d][jt] = (f32x4){0.f, 0.f, 0.f, 0.f}; }
    u32x4 rk, rv;
#define AT_LOAD(T) do { const size_t kr_ = (T) < 6 ? row0 + CTX + (size_t)((qb - 1) * 128 + (T) * 64) : row0 + (size_t)((T) - 6) * 64; \
        rk = *(const GAS u32x4*)(AK + (kr_ + (tid >> 3)) * 128 + kvh * 64 + (tid & 7) * 8); rv = *(const GAS u32x4*)(AV + (kr_ + (tid >> 3)) * 128 + kvh * 64 + (tid & 7) * 8); } while (0)
    int tix = ctxq ? 6 : (qb >= 1 ? 0 : 2);
    AT_LOAD(tix);
#pragma unroll 1
    while (tix < 10) {
        int nx = tix + 1; if (nx == 4 && qb == SEQ / 128 - 1) nx = 6;
        const bool local = tix < 6; const int kbase = (qb - 1) * 128 + tix * 64;
        __syncthreads();
        *(LAS u32x4*)(lds + A_KT + (tid >> 3) * A_KROW + (tid & 7) * 16) = rk; *(LAS u32x4*)(lds + A_VT + (tid >> 3) * A_VROW + (tid & 7) * 16) = rv;
        if (nx < 10) AT_LOAD(nx);
        __syncthreads();
        const int dq = local ? (qb * 128 + q32 * 32 - kbase) : 0; const bool partial = dq < -64 || dq > 96;
        if (dq < 192 && dq > -160) {
            bf16x8 kfr[4][2], vfr[4][2];
#pragma unroll
            for (int rt = 0; rt < 4; ++rt)
#pragma unroll
                for (int ks = 0; ks < 2; ++ks) kfr[rt][ks] = ldfrag(lds + A_KT + (16 * rt + li) * A_KROW + (32 * ks + 8 * qq) * 2);
#pragma unroll
            for (int d = 0; d < 4; ++d)
#pragma unroll
                for (int kk = 0; kk < 2; ++kk) vfr[d][kk] = trfrag(lds + A_VT + (32 * kk + 4 * qq + (li >> 2)) * A_VROW + (16 * d + 4 * (li & 3)) * 2, 16 * A_VROW);
#pragma unroll
            for (int jt = 0; jt < 2; ++jt) {
                bf16x8 qfj[2];
#pragma unroll
                for (int ks = 0; ks < 2; ++ks) qfj[ks] = ldfrag(qt + (16 * jt + li) * A_KROW + (32 * ks + 8 * qq) * 2);
                f32x4 s[4];
#pragma unroll
                for (int rt = 0; rt < 4; ++rt) { s[rt] = (f32x4){0.f, 0.f, 0.f, 0.f};
#pragma unroll
                    for (int ks = 0; ks < 2; ++ks) s[rt] = MFMA16(kfr[rt][ks], qfj[ks], s[rt]); }
                if (partial) {
                    const int qi = qb * 128 + q32 * 32 + 16 * jt + li;
#pragma unroll
                    for (int rt = 0; rt < 4; ++rt)
#pragma unroll
                        for (int e = 0; e < 4; ++e) { const int kj = kbase + 16 * rt + 4 * qq + e; const int dd = qi - kj; if (dd > 128 || dd < -128) s[rt][e] = -1e30f; }
                }
                float tm = s[0][0];
#pragma unroll
                for (int rt = 0; rt < 4; ++rt)
#pragma unroll
                    for (int e = 0; e < 4; ++e) tm = fmaxf(tm, s[rt][e]);
                tm = fmaxf(tm, __shfl_xor(tm, 16)); tm = fmaxf(tm, __shfl_xor(tm, 32));
                const float mn = fmaxf(mrun[jt], tm), alpha = __builtin_amdgcn_exp2f(mrun[jt] - mn); mrun[jt] = mn;
                float ps = 0.f;
#pragma unroll
                for (int rt = 0; rt < 4; ++rt)
#pragma unroll
                    for (int e = 0; e < 4; ++e) { const float p = __builtin_amdgcn_exp2f(s[rt][e] - mn); s[rt][e] = p; ps += p; }
                lsum[jt] = lsum[jt] * alpha + ps;
                bf16x8 pf[2]; pf[0] = pack8(s[0], s[1]); pf[1] = pack8(s[2], s[3]);
#pragma unroll
                for (int d = 0; d < 4; ++d) { f32x4 acc = o[d][jt] * alpha;
#pragma unroll
                    for (int kk = 0; kk < 2; ++kk) acc = MFMA16(vfr[d][kk], pf[kk], acc);
                    o[d][jt] = acc; }
            }
        }
        tix = nx;
    }
#undef AT_LOAD
#pragma unroll
    for (int jt = 0; jt < 2; ++jt) {
        float l = lsum[jt]; l += __shfl_xor(l, 16); l += __shfl_xor(l, 32);
        const float inv = __builtin_amdgcn_rcpf(l);
#pragma unroll
        for (int d = 0; d < 4; ++d) *(GAS u32x2*)(Og + (qrow0 + 16 * jt + li) * 2048 + 16 * d + 4 * qq) = pack4(o[d][jt] * inv);
    }
    __syncthreads();
}

DI void mixer_phase(LAS unsigned char* lds, const MixArgs& A, unsigned* ctr, int sel = 7) {
    const int total = 1216 + (A.need_ctx ? 64 : 0);
    LAS int* slot = (LAS int*)(lds + LDS_BYTES - 16);
    bool first = true;
    for (;;) {
        __syncthreads();
        if (threadIdx.x == 0) *slot = first ? (int)blockIdx.x : (int)(gridDim.x + atomicAdd(ctr, 1u));
        __syncthreads();
        first = false;
        const int u = __builtin_amdgcn_readfirstlane(*slot);
        if (u >= total) break;
        if (u < 64) { if (sel & 1) linattn_unit<true>(lds, A, u >> 3, (u >> 1) & 3, 0, u & 1); }
        else if (u < 192) { const int r = u - 64, within = r & 15, pid = (r >> 4) * 8 + (within & 7), vs = within >> 3;
            if (sel & 2) linattn_unit<false>(lds, A, pid >> 3, (pid >> 1) & 3, vs, pid & 1); }
        else if (u < 1216) { const int v = u - 192; if (sel & 4) attn_unit(lds, A, v >> 7, (v >> 6) & 1, (v >> 1) & 31, v & 1, false); }
        else { const int v = u - 1216; if (sel & 4) attn_unit(lds, A, v >> 3, (v >> 2) & 1, (v >> 1) & 1, v & 1, true); }
    }
}
struct Params { const float* in[24]; float* out; unsigned char* ws; };
enum { I_X = 0, I_C, I_CTX, I_CCTX, I_MODW, I_MODB, I_N1W, I_N2W, I_WIN, I_MGB, I_MCW, I_MNW, I_SINK, I_RLOG, I_RNW, I_BRM, I_BRA, I_BRR, I_WOUT, I_UP, I_FCW, I_FCB, I_DN, I_FNW };

DI int map_in(int n) {
    if (n < 2048) return n;
    if (n < 2064) return -1;
    if (n < 2704) { const int off = n - 2064, blk = off >> 5, w = off & 31, i = w & 15, hi = w >> 4; return 2048 + blk * 32 + 8 * (i >> 2) + 4 * hi + (i & 3); }
    if (n < 2832) return n - 16;
    if (n < 3856) { const int off = n - 2832, head = off >> 7, dim = off & 127, g = (dim & 63) >> 4, idx = dim & 15, hi = dim >> 6; return 2816 + head * 128 + 32 * g + 8 * (idx >> 2) + 4 * hi + (idx & 3); }
    return n - 16;
}
DI int map_up(int n) { const int hb = n >= FFN, s = hb ? n - FFN : n; return (s >> 7) * 256 + hb * 128 + (s & 127); }
DI void transpose_item(const float* W, int K, int N, bf16_t* WT, int ldw, int koff, int mode, LAS float* scr, int item, int lane) {
    const int nblk = (N + 31) / 32, kb = item / nblk, nb = item - kb * nblk, k0 = 64 * kb, n0 = 32 * nb;
    const int nl = n0 + (lane & 31);
    float tv[32];
#pragma unroll
    for (int i = 0; i < 32; ++i) { const int kk = 2 * i + (lane >> 5); tv[i] = nl < N ? W[(size_t)(k0 + kk) * N + nl] : 0.f; }
#pragma unroll
    for (int i = 0; i < 32; ++i) { const int kk = 2 * i + (lane >> 5); scr[kk * 33 + (lane & 31)] = tv[i]; }
    asm volatile("s_waitcnt lgkmcnt(0)" ::: "memory");
    const int c = lane & 7;
#pragma unroll
    for (int j = 0; j < 4; ++j) { const int nn = (lane >> 3) + 8 * j, n = n0 + nn; const LAS float* s = scr + (8 * c) * 33 + nn;
        u32x4 o; o.x = cvt_pk_bf16(s[0 * 33], s[1 * 33]); o.y = cvt_pk_bf16(s[2 * 33], s[3 * 33]); o.z = cvt_pk_bf16(s[4 * 33], s[5 * 33]); o.w = cvt_pk_bf16(s[6 * 33], s[7 * 33]);
        const int dr = n < N ? (mode == 1 ? map_in(n) : (mode == 2 ? map_up(n) : n)) : -1;
        if (dr >= 0) *(GAS u32x4*)(WT + (size_t)dr * ldw + koff + k0 + 8 * c) = o; }
    asm volatile("s_waitcnt lgkmcnt(0)" ::: "memory");
}
DI float wave_sum(float v) {
#pragma unroll
    for (int o = 1; o < 64; o <<= 1) v += __shfl_xor(v, o);
    return v;
}
DI void p0_prologue(const Params& p, LAS unsigned char* lds) {
    const int tid = lv(threadIdx.x), wid = __builtin_amdgcn_readfirstlane(tid >> 6), lane = tid & 63, G = gridDim.x;
    {
        LAS float* scr = (LAS float*)(lds + wid * 8448);
        constexpr int I_IN = 16 * 281, I_BM = 8 * 32, I_BR = 16 * 32, I_O = 16 * 32, I_U = 16 * 176, I_D = 44 * 32, PER = I_IN + 2 * I_BM + I_BR + I_O + I_U + I_D;
        for (int it = blockIdx.x * 8 + wid; it < 2 * PER; it += G * 8) {
            const int l = it / PER; int r = it - l * PER; unsigned char* wb = p.ws + WS_W + (size_t)l * W_LAYER;
            if (r < I_IN) { transpose_item(p.in[I_WIN] + (size_t)l * D * IN_COLS, D, IN_COLS, (bf16_t*)(wb + WO_IN), 1024, 0, 1, scr, r, lane); continue; } r -= I_IN;
            if (r < I_BM) { transpose_item(p.in[I_BRM] + (size_t)l * 512 * D, 512, D, (bf16_t*)(wb + WO_BR), 2048, 0, 0, scr, r, lane); continue; } r -= I_BM;
            if (r < I_BM) { transpose_item(p.in[I_BRA] + (size_t)l * 512 * D, 512, D, (bf16_t*)(wb + WO_BR), 2048, 512, 0, scr, r, lane); continue; } r -= I_BM;
            if (r < I_BR) { transpose_item(p.in[I_BRR] + (size_t)l * D * D, D, D, (bf16_t*)(wb + WO_BR), 2048, 1024, 0, scr, r, lane); continue; } r -= I_BR;
            if (r < I_O) { transpose_item(p.in[I_WOUT] + (size_t)l * D * D, D, D, (bf16_t*)(wb + WO_OUT), 1024, 0, 0, scr, r, lane); continue; } r -= I_O;
            if (r < I_U) { transpose_item(p.in[I_UP] + (size_t)l * D * 2 * FFN, D, 2 * FFN, (bf16_t*)(wb + WO_UP), 1024, 0, 2, scr, r, lane); continue; } r -= I_U;
            transpose_item(p.in[I_DN] + (size_t)l * FFN * D, FFN, D, (bf16_t*)(wb + WO_DN), FFN, 0, 0, scr, r, lane);
        }
    }
    {
        LAS float* st = (LAS float*)lds; LAS float* red = (LAS float*)(lds + 69632);
        float* MOD = (float*)(p.ws + WS_MOD);
        for (int u = blockIdx.x; u < 192; u += G) {
            const int l = u / 96, n0 = (u - l * 96) * 64;
            __syncthreads();
            for (int i = tid; i < 17 * 1024; i += 512) { const int v = i >> 10, k = i & 1023; const float cv = v < 16 ? p.in[I_C][v * 1024 + k] : p.in[I_CCTX][k]; st[i] = cv / (1.f + expf(-cv)); }
            __syncthreads();
            const int col = tid & 63, kp = tid >> 6;
            float acc[17];
#pragma unroll
            for (int v = 0; v < 17; ++v) acc[v] = 0.f;
            const float* wp = p.in[I_MODW] + ((size_t)l * 1024 + kp * 128) * 6144 + n0 + col;
#pragma unroll 16
            for (int k = 0; k < 128; ++k) { const float w = wp[(size_t)k * 6144];
#pragma unroll
                for (int v = 0; v < 17; ++v) acc[v] += st[v * 1024 + kp * 128 + k] * w; }
#pragma unroll
            for (int v = 0; v < 17; ++v) red[(kp * 17 + v) * 64 + col] = acc[v];
            __syncthreads();
            for (int i = tid; i < 17 * 64; i += 512) { const int v = i >> 6, cc = i & 63; float s = 0.f;
#pragma unroll
                for (int q = 0; q < 8; ++q) s += red[(q * 17 + v) * 64 + cc];
                MOD[((size_t)l * 17 + v) * 6144 + n0 + cc] = s + p.in[I_MODB][l * 6144 + n0 + cc]; }
        }
        __syncthreads();
    }
    {
        float* tab = (float*)(p.ws + WS_TAB);
        for (int idx = blockIdx.x * 512 + tid; idx < PT * 64 + 1024; idx += G * 512) {
            int pos, ti; float inv;
            if (idx < PT * 64) { pos = idx >> 6; const int i = idx & 63; inv = exp2f(-(float)i * (13.287712379549449f / 64.f)); ti = idx; }
            else { const int k = idx - PT * 64; pos = k >> 4; const int i = k & 15; inv = exp2f(-(float)i * (13.287712379549449f / 16.f)); ti = k; }
            const double ang = (double)pos * (double)inv; const double rev = ang * 0.15915494309189535; const double fr = rev - __builtin_rint(rev);
            const float a = (float)(fr * 6.283185307179586);
            const float cs = __cosf(a), sn = __sinf(a);
            if (idx < PT * 64) { tab[TAB_COSR + ti] = cs; tab[TAB_SINR + ti] = sn; } else { tab[TAB_COSA + ti] = cs; tab[TAB_SINA + ti] = sn; }
        }
    }
}

DI void norm_phase(const Params& p, LAS unsigned char* lds, int half, int l, int which, int first, int skip_ctx) {
    const int tid = lv(threadIdx.x), wid = __builtin_amdgcn_readfirstlane(tid >> 6), lane = tid & 63, G = gridDim.x;
    LAS float* wg = (LAS float*)lds;
    if (which == 0) {
        __syncthreads();
        const float* win = p.in[I_WIN] + (size_t)l * D * IN_COLS;
        for (int i = tid; i < 16384; i += 512) { const int k = i >> 4, g = i & 15; wg[g * 1024 + k] = win[(size_t)k * IN_COLS + 2048 + g]; }
        __syncthreads();
    }
    const float* MOD = (const float*)(p.ws + WS_MOD);
    const float* nw = p.in[which ? I_N2W : I_N1W] + l * D;
    bf16_t* HN = (bf16_t*)(p.ws + WS_HN);
    float* MG = (float*)(p.ws + PO_MG);
    float* xc = (float*)(p.ws + WS_XC);
#define NP_SRC(R, PTR) do { const int bl_ = (R) / PT, pp_ = (R) - bl_ * PT, b_ = half * HB + bl_; const bool c_ = pp_ < CTX; \
        const size_t ro_ = c_ ? ((size_t)b_ * CTX + pp_) * D : ((size_t)b_ * SEQ + (pp_ - CTX)) * D; \
        PTR = first ? ((c_ ? p.in[I_CTX] : p.in[I_X]) + ro_) : ((c_ ? xc : p.out) + ro_); } while (0)
    f32x4 vn[4];
    { const int r0 = blockIdx.x * 8 + wid; if (r0 < MH) { const float* s0; NP_SRC(r0, s0);
#pragma unroll
        for (int j = 0; j < 4; ++j) vn[j] = *(const GAS f32x4*)(s0 + 4 * (lane + 64 * j)); } }
    for (int r = blockIdx.x * 8 + wid; r < MH; r += G * 8) {
        const int bl = r / PT, pp = r - bl * PT, b = half * HB + bl; const bool is_ctx = pp < CTX;
        f32x4 v[4];
#pragma unroll
        for (int j = 0; j < 4; ++j) v[j] = vn[j];
        { const int r2 = r + G * 8; if (r2 < MH) { const float* s2; NP_SRC(r2, s2);
#pragma unroll
            for (int j = 0; j < 4; ++j) vn[j] = *(const GAS f32x4*)(s2 + 4 * (lane + 64 * j)); } }
        if (is_ctx && skip_ctx) continue;
        const float* mod = MOD + ((size_t)l * 17 + (is_ctx ? 16 : b)) * 6144;
        const float* sh = mod + (which ? 3 : 0) * 1024; const float* sc = mod + (which ? 4 : 1) * 1024;
        float ss = 0.f;
#pragma unroll
        for (int j = 0; j < 4; ++j) ss += v[j][0] * v[j][0] + v[j][1] * v[j][1] + v[j][2] * v[j][2] + v[j][3] * v[j][3];
        const float rstd = rsqrtf(wave_sum(ss) * (1.f / D) + 1e-6f);
#pragma unroll
        for (int j = 0; j < 4; ++j) { const int c = 4 * (lane + 64 * j);
            const f32x4 w4 = *(const GAS f32x4*)(nw + c), s4 = *(const GAS f32x4*)(sc + c), h4 = *(const GAS f32x4*)(sh + c);
            v[j] = v[j] * rstd * w4 * (s4 + 1.f) + h4;
            *(GAS u32x2*)(HN + (size_t)r * D + c) = pack4(v[j]); }
        if (which == 0) {
            float part[16];
#pragma unroll
            for (int g = 0; g < 16; ++g) { float a = 0.f;
#pragma unroll
                for (int j = 0; j < 4; ++j) { const f32x4 w4 = *(const LAS f32x4*)(wg + g * 1024 + 4 * (lane + 64 * j)); a += v[j][0] * w4[0] + v[j][1] * w4[1] + v[j][2] * w4[2] + v[j][3] * w4[3]; }
                part[g] = a; }
            float p8[8], p4[4], p2[2], p1;
            { const bool hi = lane & 32;
#pragma unroll
                for (int j = 0; j < 8; ++j) { const float keep = hi ? part[j + 8] : part[j], send = hi ? part[j] : part[j + 8]; p8[j] = keep + __shfl_xor(send, 32); } }
            { const bool hi = lane & 16;
#pragma unroll
                for (int j = 0; j < 4; ++j) { const float keep = hi ? p8[j + 4] : p8[j], send = hi ? p8[j] : p8[j + 4]; p4[j] = keep + __shfl_xor(send, 16); } }
            { const bool hi = lane & 8;
#pragma unroll
                for (int j = 0; j < 2; ++j) { const float keep = hi ? p4[j + 2] : p4[j], send = hi ? p4[j] : p4[j + 2]; p2[j] = keep + __shfl_xor(send, 8); } }
            { const bool hi = lane & 4; const float keep = hi ? p2[1] : p2[0], send = hi ? p2[0] : p2[1]; p1 = keep + __shfl_xor(send, 4); }
            p1 += __shfl_xor(p1, 1); p1 += __shfl_xor(p1, 2);
            const int gidx = ((lane >> 5) & 1) * 8 + ((lane >> 4) & 1) * 4 + ((lane >> 3) & 1) * 2 + ((lane >> 2) & 1);
            if ((lane & 3) == 0) { float val = p1 + p.in[I_MGB][l * 16 + gidx]; if ((gidx >> 2) & 1) val = logsigmoidf_(val); MG[(size_t)r * 16 + gidx] = val; }
        }
    }
}

DI void postmix_phase(const Params& p, int l, int skip_ctx) {
    const int tid = lv(threadIdx.x), wid = __builtin_amdgcn_readfirstlane(tid >> 6), lane = tid & 63, G = gridDim.x;
    bf16_t* Y = (bf16_t*)(p.ws + WS_YCAT); const bf16_t* MO = (const bf16_t*)(p.ws + PO_MO); const bf16_t* RG = (const bf16_t*)(p.ws + PO_RG);
    const bf16_t* HMB = (const bf16_t*)(p.ws + WS_HMB); const bf16_t* HRB = (const bf16_t*)(p.ws + WS_HRB);
    const float* mnw = p.in[I_MNW] + l * 512; const float* rnw = p.in[I_RNW] + l * 1024;
    float wm[8], wr_[16];
#pragma unroll
    for (int h = 0; h < 2; ++h) { const f32x4 t = *(const GAS f32x4*)(mnw + 8 * lane + 4 * h);
#pragma unroll
        for (int e = 0; e < 4; ++e) wm[4 * h + e] = t[e]; }
#pragma unroll
    for (int h = 0; h < 4; ++h) { const f32x4 t = *(const GAS f32x4*)(rnw + 16 * lane + 4 * h);
#pragma unroll
        for (int e = 0; e < 4; ++e) wr_[4 * h + e] = t[e]; }
    for (int r = blockIdx.x * 8 + wid; r < MH; r += G * 8) {
        const int pp = r % PT; if (pp < CTX && skip_ctx) continue;
        bf16_t* ym = Y + (size_t)r * 2048 + 8 * lane; bf16_t* yr = Y + (size_t)r * 2048 + 1024 + 16 * lane;
        const bf16_t* gp = RG + (size_t)r * 1024 + 16 * lane; const bf16_t* bp = HRB + (size_t)r * 1024 + 16 * lane;
        const u32x4 mraw = *(const GAS u32x4*)ym, mrb = *(const GAS u32x4*)(HMB + (size_t)r * 512 + 8 * lane), mgt = *(const GAS u32x4*)(MO + (size_t)r * 512 + 8 * lane);
        u32x4 raw[2], rb[2], gt[2]; raw[0] = *(const GAS u32x4*)yr; raw[1] = *(const GAS u32x4*)(yr + 8); gt[0] = *(const GAS u32x4*)gp; gt[1] = *(const GAS u32x4*)(gp + 8); rb[0] = *(const GAS u32x4*)bp; rb[1] = *(const GAS u32x4*)(bp + 8);
        {
            float x[8]; float s = 0.f;
#pragma unroll
            for (int e = 0; e < 4; ++e) { x[2 * e] = bflo(mraw[e]) + bflo(mrb[e]); x[2 * e + 1] = bfhi(mraw[e]) + bfhi(mrb[e]); s += x[2 * e] + x[2 * e + 1]; }
            s += __shfl_xor(s, 1); s += __shfl_xor(s, 2); s += __shfl_xor(s, 4); s += __shfl_xor(s, 8);
            const float mu = s * (1.f / 128.f); float q = 0.f;
#pragma unroll
            for (int e = 0; e < 8; ++e) { x[e] -= mu; q += x[e] * x[e]; }
            q += __shfl_xor(q, 1); q += __shfl_xor(q, 2); q += __shfl_xor(q, 4); q += __shfl_xor(q, 8);
            const float rs = rsqrtf(q * (1.f / 128.f) + 1e-6f);
            u32x4 o;
#pragma unroll
            for (int e = 0; e < 4; ++e) { const float a = x[2 * e] * rs * wm[2 * e] * bflo(mgt[e]), b2 = x[2 * e + 1] * rs * wm[2 * e + 1] * bfhi(mgt[e]); o[e] = cvt_pk_bf16(a, b2); }
            *(GAS u32x4*)ym = o;
        }
        {
            float x[16]; float s = 0.f;
#pragma unroll
            for (int e = 0; e < 8; ++e) { x[2 * e] = bflo(raw[e >> 2][e & 3]) + bflo(rb[e >> 2][e & 3]); x[2 * e + 1] = bfhi(raw[e >> 2][e & 3]) + bfhi(rb[e >> 2][e & 3]); s += x[2 * e] + x[2 * e + 1]; }
            s += __shfl_xor(s, 1); s += __shfl_xor(s, 2); s += __shfl_xor(s, 4); s += __shfl_xor(s, 8);
            const float mu = s * (1.f / 256.f); float q = 0.f;
#pragma unroll
            for (int e = 0; e < 16; ++e) { x[e] -= mu; q += x[e] * x[e]; }
            q += __shfl_xor(q, 1); q += __shfl_xor(q, 2); q += __shfl_xor(q, 4); q += __shfl_xor(q, 8);
            const float rs = rsqrtf(q * (1.f / 256.f) + 1e-6f);
            u32x4 o[2];
#pragma unroll
            for (int e = 0; e < 8; ++e) { const float a = x[2 * e] * rs * wr_[2 * e] * bflo(gt[e >> 2][e & 3]), b2 = x[2 * e + 1] * rs * wr_[2 * e + 1] * bfhi(gt[e >> 2][e & 3]); o[e >> 2][e & 3] = cvt_pk_bf16(a, b2); }
            *(GAS u32x4*)yr = o[0]; *(GAS u32x4*)(yr + 8) = o[1];
        }
    }
}

DI void edge_phase(const Params& p, int l, int skip_ctx) {
    const int tid = lv(threadIdx.x), G = gridDim.x;
    const bf16_t* SA = (const bf16_t*)(p.ws + WS_SA); const bf16_t* SB = (const bf16_t*)(p.ws + WS_SB); bf16_t* U = (bf16_t*)(p.ws + WS_FB);
    constexpr int NCG = FFN / 8, NT = (MH / 64) * 2 * NCG;
    for (int t = blockIdx.x * 512 + tid; t < NT; t += G * 512) {
        const int cg = t % NCG, bw = t / NCG, which = bw & 1, blk = bw >> 1, c0 = cg * 8;
        const int r = blk * 64 + (which ? 63 : 0), pp = r % PT;
        if (pp < CTX && skip_ctx) continue;
        const u32x4 z = (u32x4){0u, 0u, 0u, 0u};
        u32x4 ap, ac, an, bb;
        if (!which) { const bool pv = !(pp == 0 || pp == CTX);
            ap = pv ? *(const GAS u32x4*)(SA + ((size_t)(blk - 1) * 4 + 3) * FFN + c0) : z; ac = *(const GAS u32x4*)(SA + ((size_t)blk * 4 + 0) * FFN + c0); an = *(const GAS u32x4*)(SA + ((size_t)blk * 4 + 1) * FFN + c0);
            bb = *(const GAS u32x4*)(SB + ((size_t)blk * 2 + 0) * FFN + c0);
        } else { const bool nv = !(pp + 1 == CTX || pp + 1 == PT);
            ap = *(const GAS u32x4*)(SA + ((size_t)blk * 4 + 2) * FFN + c0); ac = *(const GAS u32x4*)(SA + ((size_t)blk * 4 + 3) * FFN + c0); an = nv ? *(const GAS u32x4*)(SA + ((size_t)(blk + 1) * 4 + 0) * FFN + c0) : z;
            bb = *(const GAS u32x4*)(SB + ((size_t)blk * 2 + 1) * FFN + c0);
        }
        float w0[8], w1[8], w2[8], bs[8];
#pragma unroll
        for (int h = 0; h < 2; ++h) {
            const f32x4 x0 = *(const GAS f32x4*)(p.in[I_FCW] + (l * 3 + 0) * FFN + c0 + 4 * h), x1 = *(const GAS f32x4*)(p.in[I_FCW] + (l * 3 + 1) * FFN + c0 + 4 * h);
            const f32x4 x2 = *(const GAS f32x4*)(p.in[I_FCW] + (l * 3 + 2) * FFN + c0 + 4 * h), xb = *(const GAS f32x4*)(p.in[I_FCB] + l * FFN + c0 + 4 * h);
#pragma unroll
            for (int e = 0; e < 4; ++e) { w0[4 * h + e] = x0[e]; w1[4 * h + e] = x1[e]; w2[4 * h + e] = x2[e]; bs[4 * h + e] = xb[e]; }
        }
        u32x4 o;
#pragma unroll
        for (int e = 0; e < 4; ++e) {
            const float t0 = w0[2 * e] * bflo(ap[e]) + w1[2 * e] * bflo(ac[e]) + w2[2 * e] * bflo(an[e]) + bs[2 * e];
            const float t1 = w0[2 * e + 1] * bfhi(ap[e]) + w1[2 * e + 1] * bfhi(ac[e]) + w2[2 * e + 1] * bfhi(an[e]) + bs[2 * e + 1];
            o[e] = cvt_pk_bf16(siluf_(t0) * bflo(bb[e]), siluf_(t1) * bfhi(bb[e]));
        }
        *(GAS u32x4*)(U + (size_t)r * FFN + c0) = o;
    }
}

DI void qk_edge_phase(const Params& p, int l) {
    const int tid = lv(threadIdx.x), G = gridDim.x;
    const bf16_t* SQ = (const bf16_t*)(p.ws + WS_SQ);
    constexpr int NCG = 128, NT = (MH / 64) * 2 * NCG;
    for (int t = blockIdx.x * 512 + tid; t < NT; t += G * 512) {
        const int cg = t % NCG, bw = t / NCG, wh = bw & 1, blk = bw >> 1, c0 = cg * 8, which = cg >> 6;
        const int r = blk * 64 + (wh ? 63 : 0), pp = r % PT;
        const u32x4 z = (u32x4){0u, 0u, 0u, 0u};
        u32x4 ap, ac, an;
        if (!wh) { const bool pv = !(pp == 0 || pp == CTX);
            ap = pv ? *(const GAS u32x4*)(SQ + ((size_t)(blk - 1) * 4 + 3) * 1024 + c0) : z; ac = *(const GAS u32x4*)(SQ + ((size_t)blk * 4 + 0) * 1024 + c0); an = *(const GAS u32x4*)(SQ + ((size_t)blk * 4 + 1) * 1024 + c0);
        } else { const bool nv = !(pp + 1 == CTX || pp + 1 == PT);
            ap = *(const GAS u32x4*)(SQ + ((size_t)blk * 4 + 2) * 1024 + c0); ac = *(const GAS u32x4*)(SQ + ((size_t)blk * 4 + 3) * 1024 + c0); an = nv ? *(const GAS u32x4*)(SQ + ((size_t)(blk + 1) * 4 + 0) * 1024 + c0) : z;
        }
        const float* cw = p.in[I_MCW] + l * 3 * 1024 + c0;
        float w0[8], w1[8], w2[8];
#pragma unroll
        for (int h = 0; h < 2; ++h) { const f32x4 x0 = *(const GAS f32x4*)(cw + 4 * h), x1 = *(const GAS f32x4*)(cw + 1024 + 4 * h), x2 = *(const GAS f32x4*)(cw + 2048 + 4 * h);
#pragma unroll
            for (int e = 0; e < 4; ++e) { w0[4 * h + e] = x0[e]; w1[4 * h + e] = x1[e]; w2[4 * h + e] = x2[e]; } }
        const float sc = which ? 0.08838834764831845f : 1.f;
        u32x4 o;
#pragma unroll
        for (int e = 0; e < 4; ++e) {
            const float t0 = w0[2 * e] * bflo(ap[e]) + w1[2 * e] * bflo(ac[e]) + w2[2 * e] * bflo(an[e]);
            const float t1 = w0[2 * e + 1] * bfhi(ap[e]) + w1[2 * e + 1] * bfhi(ac[e]) + w2[2 * e + 1] * bfhi(an[e]);
            o[e] = cvt_pk_bf16(siluf_(t0) * sc, siluf_(t1) * sc);
        }
        bf16_t* dst = (bf16_t*)(p.ws + (which ? PO_MKC : PO_MQC));
        *(GAS u32x4*)(dst + (size_t)r * 512 + (c0 & 511)) = o;
    }
}

DI void final_norm_phase(const Params& p, int half) {
    const int tid = lv(threadIdx.x), wid = __builtin_amdgcn_readfirstlane(tid >> 6), lane = tid & 63, G = gridDim.x;
    const float* fw = p.in[I_FNW];
    f32x4 vn[4];
    { const int r0 = blockIdx.x * 8 + wid; if (r0 < HB * SEQ) { const float* s0 = p.out + ((size_t)half * HB * SEQ + r0) * D;
#pragma unroll
        for (int j = 0; j < 4; ++j) vn[j] = *(const GAS f32x4*)(s0 + 4 * (lane + 64 * j)); } }
    for (int r = blockIdx.x * 8 + wid; r < HB * SEQ; r += G * 8) {
        float* xr = p.out + ((size_t)half * HB * SEQ + r) * D;
        f32x4 v[4]; float ss = 0.f;
#pragma unroll
        for (int j = 0; j < 4; ++j) { v[j] = vn[j]; ss += v[j][0] * v[j][0] + v[j][1] * v[j][1] + v[j][2] * v[j][2] + v[j][3] * v[j][3]; }
        { const int r2 = r + G * 8; if (r2 < HB * SEQ) { const float* s2 = p.out + ((size_t)half * HB * SEQ + r2) * D;
#pragma unroll
            for (int j = 0; j < 4; ++j) vn[j] = *(const GAS f32x4*)(s2 + 4 * (lane + 64 * j)); } }
        const float rstd = rsqrtf(wave_sum(ss) * (1.f / D) + 1e-6f);
#pragma unroll
        for (int j = 0; j < 4; ++j) { const f32x4 w4 = *(const GAS f32x4*)(fw + 4 * (lane + 64 * j)); *(GAS f32x4*)(xr + 4 * (lane + 64 * j)) = v[j] * rstd * w4; }
    }
}

#define XB_TMO      128
#define XB_XCNT(j)  (256  + 64 * (j))
#define XB_XSUB(j)  (1280 + 64 * (j))
#define XB_XGEN(j)  (2304 + 64 * (j))
#define XB_TOP      3328
#define XB_TOPGEN   3392
#define XCD_BAR_WORDS 3456
#define XB_SPIN_CAP (1u << 18)

__device__ __forceinline__ unsigned xb_ld(unsigned* p)              { return __hip_atomic_load(p, __ATOMIC_RELAXED, __HIP_MEMORY_SCOPE_AGENT); }
__device__ __forceinline__ unsigned xb_add(unsigned* p, unsigned v) { return __hip_atomic_fetch_add(p, v, __ATOMIC_RELAXED, __HIP_MEMORY_SCOPE_AGENT); }
__device__ __forceinline__ unsigned xb_xcc_id() { return (unsigned)__builtin_amdgcn_s_getreg((3 << 11) | 20) & 0xFu; }
#define XB_SPIN(cond, bar) do { unsigned _sp = 0; while (cond) { __builtin_amdgcn_s_sleep(1); \
    if ((++_sp & 255u) == 0u) { if (xb_ld(&(bar)[XB_TMO])) break; if (_sp > XB_SPIN_CAP) { atomicAdd(&(bar)[XB_TMO], 1u); break; } } } } while (0)

struct XcdBarrier {
    unsigned* bar; unsigned x;
    volatile LAS unsigned* st;
};

__device__ __forceinline__ XcdBarrier xcd_barrier_post(unsigned* bar, volatile LAS unsigned* st) {
    XcdBarrier b; b.bar = bar; b.x = xb_xcc_id(); b.st = st;
    if (threadIdx.x == 0) (void)xb_add(&bar[XB_XCNT(b.x)], 1u);
    return b;
}
__device__ __forceinline__ void xcd_barrier_complete(unsigned* bar, unsigned x, unsigned& nloc, unsigned& nx) {
    const unsigned G = gridDim.x * gridDim.y * gridDim.z;
    unsigned sum, cnt, mine, sp = 0u;
    for (;;) {
        sum = 0u; cnt = 0u; mine = 0u;
#pragma unroll
        for (unsigned j = 0; j < 16; ++j) { const unsigned c = xb_ld(&bar[XB_XCNT(j)]); sum += c; cnt += (c > 0u) ? 1u : 0u; mine = (j == x) ? c : mine; }
        if (sum == G) break;
        __builtin_amdgcn_s_sleep(1);
        if ((++sp & 255u) == 0u) { if (xb_ld(&bar[XB_TMO])) break; if (sp > XB_SPIN_CAP) { atomicAdd(&bar[XB_TMO], 1u); break; } }
    }
    nloc = mine > 0u ? mine : 1u; nx = cnt > 0u ? cnt : 1u;
}

__device__ __forceinline__ void xcd_barrier(const XcdBarrier& b) {
    asm volatile("s_waitcnt vmcnt(0)" ::: "memory");
    __syncthreads();
    if (threadIdx.x == 0) {
        unsigned* bar = b.bar;
        __builtin_amdgcn_s_waitcnt(0);
        unsigned nloc = b.st[0], nx = b.st[1];
        if (nloc == 0u) { xcd_barrier_complete(bar, b.x, nloc, nx); b.st[0] = nloc; b.st[1] = nx; }
        const unsigned old = xb_add(&bar[XB_XSUB(b.x)], 1u);
        const unsigned gen = old / nloc;
        if (old + 1u == (gen + 1u) * nloc) {
            __builtin_amdgcn_fence(__ATOMIC_RELEASE, "agent");
            asm volatile("s_waitcnt vmcnt(0)" ::: "memory");
            const unsigned og = xb_add(&bar[XB_TOP], 1u);
            const unsigned tg = og / nx;
            if (og + 1u == (tg + 1u) * nx) xb_add(&bar[XB_TOPGEN], 1u);
            else XB_SPIN(xb_ld(&bar[XB_TOPGEN]) == tg, bar);
            __builtin_amdgcn_fence(__ATOMIC_ACQUIRE, "agent");
            xb_add(&bar[XB_XGEN(b.x)], 1u);
            asm volatile("s_waitcnt vmcnt(0)" ::: "memory");
        } else {
            XB_SPIN(xb_ld(&bar[XB_XGEN(b.x)]) == gen, bar);
            __builtin_amdgcn_fence(__ATOMIC_ACQUIRE, "agent");
            asm volatile("s_waitcnt vmcnt(0)" ::: "memory");
        }
    }
    __syncthreads();
}


constexpr int CW_BAR = 4096;
__global__ void __launch_bounds__(512, 2) mk_fwd(Params p) {
    extern __shared__ __attribute__((aligned(16))) unsigned char lds_raw[];
    LAS unsigned char* lds = (LAS unsigned char*)lds_raw;
    cg::grid_group grid = cg::this_grid();
    volatile LAS unsigned* bst = (volatile LAS unsigned*)(lds + LDS_BYTES - 32);
    if (threadIdx.x == 0) { bst[0] = 0u; bst[1] = 0u; }
    __syncthreads();
    const XcdBarrier xbar = xcd_barrier_post((unsigned*)(p.ws + WS_CTL) + CW_BAR, bst);
    const int G = gridDim.x, bx = blockIdx.x;
#define RELOAD_WS() do { asm volatile("" : "+s"(p.ws)); p.ws = (unsigned char*)(GAS unsigned char*)p.ws; ws = p.ws; } while (0)
    unsigned char* ws = p.ws;
    PH(0) p0_prologue(p, lds);
    if (p.out == nullptr) grid.sync();
    xcd_barrier(xbar); RELOAD_WS();
    for (int half = 0; half < 2; ++half) {
        for (int l = 0; l < 2; ++l) {
            const int last = (l == 1), first = (l == 0);
#define wb (ws + WS_W + (size_t)l * W_LAYER)
#define MODl ((const float*)(ws + WS_MOD) + (size_t)l * 17 * 6144)
            PH(1) for (int rep = 0; rep < NREP(1); ++rep) norm_phase(p, lds, half, l, 0, first, 0);
            xcd_barrier(xbar); RELOAD_WS();
            PH(2) for (int rep = 0; rep < NREP(2); ++rep) {
                EpiIn E{ws, (const float*)(ws + WS_TAB), p.in[I_MCW] + l * 3 * 1024};
                if (!last) {
                    pg8::Sched1 S; S.o.init(MH, N_IN, G, bx); S.A = (const char*)(ws + WS_HN); S.B = (const char*)(wb + WO_IN); S.tsA = (size_t)256 * 1024 * 2; S.tsB = (size_t)256 * 1024 * 2; S.nt = 16;
                    pg8::gemm_phase(lds, 1024, 1024, S, E);
                } else {
                    pg8::SchedInLast S; S.o.init(MH, N_IN, G, bx, 1); S.A = (const char*)(ws + WS_HN); S.B = (const char*)(wb + WO_IN); S.tsA = (size_t)256 * 1024 * 2; S.tsB = (size_t)256 * 1024 * 2; S.nt = 16;
                    pg8::gemm_phase(lds, 1024, 1024, S, E);
                }
            }
            xcd_barrier(xbar); RELOAD_WS();
            qk_edge_phase(p, l);
            xcd_barrier(xbar); RELOAD_WS();
            PH(3) for (int rep = 0; rep < NREP(3); ++rep) {
                MixArgs A{ws, p.in[I_MCW] + l * 3 * 1024, p.in[I_SINK] + l * 8, p.in[I_RLOG] + l * 8, !last};
                mixer_phase(lds, A, (unsigned*)(ws + WS_CTL) + 64 * (half * 2 + l) + 256 * rep, rep ? PROBE_SEL : 7);
                if (rep + 1 < NREP(3)) xcd_barrier(xbar);
            }
            xcd_barrier(xbar); RELOAD_WS();
            PH(4) postmix_phase(p, l, last);
            xcd_barrier(xbar); RELOAD_WS();
            PH(5) for (int rep = 0; rep < NREP(5); ++rep) {
                pg8::Sched3 S; S.o.init(MH, 1024, G, bx, last); S.A = (const char*)(ws + WS_YCAT); S.B = (const char*)(wb + WO_BR); S.tsA = (size_t)256 * 2048 * 2; S.tsB = (size_t)256 * 2048 * 2;
                EpiBr E{(bf16_t*)(ws + WS_HN), (const bf16_t*)(ws + PO_G3)};
                pg8::gemm_phase(lds, 2048, 2048, S, E);
            }
            xcd_barrier(xbar); RELOAD_WS();
            PH(6) {
                pg8::Sched1 S; S.o.init(MH, 1024, G, bx, last); S.A = (const char*)(ws + WS_HN); S.B = (const char*)(wb + WO_OUT); S.tsA = (size_t)256 * 1024 * 2; S.tsB = (size_t)256 * 1024 * 2; S.nt = 16;
                EpiRes E{p.in[I_X], p.in[I_CTX], p.out, (float*)(ws + WS_XC), MODl + 2 * 1024, half, first, last};
                pg8::gemm_phase(lds, 1024, 1024, S, E);
            }
            xcd_barrier(xbar); RELOAD_WS();
            PH(7) for (int rep = 0; rep < NREP(7); ++rep) norm_phase(p, lds, half, l, 1, 0, last);
            xcd_barrier(xbar); RELOAD_WS();
            PH(8) for (int rep = 0; rep < NREP(8); ++rep) {
                pg8::Sched1 S; S.o.init(MH, 2 * FFN, G, bx, last); S.A = (const char*)(ws + WS_HN); S.B = (const char*)(wb + WO_UP); S.tsA = (size_t)256 * 1024 * 2; S.tsB = (size_t)256 * 1024 * 2; S.nt = 16;
                EpiUp E{(bf16_t*)(ws + WS_FB), (bf16_t*)(ws + WS_SA), (bf16_t*)(ws + WS_SB), p.in[I_FCW] + l * 3 * FFN, p.in[I_FCB] + l * FFN};
                pg8::gemm_phase(lds, 1024, 1024, S, E);
            }
            xcd_barrier(xbar); RELOAD_WS();
            PH(9) edge_phase(p, l, last);
            xcd_barrier(xbar); RELOAD_WS();
            PH(10) {
                pg8::Sched1 S; S.o.init(MH, 1024, G, bx, last); S.A = (const char*)(ws + WS_FB); S.B = (const char*)(wb + WO_DN); S.tsA = (size_t)256 * FFN * 2; S.tsB = (size_t)256 * FFN * 2; S.nt = FFN / 64;
                EpiRes E{p.in[I_X], p.in[I_CTX], p.out, (float*)(ws + WS_XC), MODl + 5 * 1024, half, 0, last};
                pg8::gemm_phase(lds, FFN, FFN, S, E);
            }
            xcd_barrier(xbar); RELOAD_WS();
        }
        PH(11) final_norm_phase(p, half);
    }
}

extern "C" void kernel_launch(void* const* d_in, const int* in_sizes, int n_in, void* d_out, int out_size, void* d_ws, size_t ws_size, hipStream_t stream) {
    static int grid = 0;
    if (grid == 0) {
        int dev = 0, cus = 0, per_cu = 0;
        (void)hipGetDevice(&dev);
        (void)hipDeviceGetAttribute(&cus, hipDeviceAttributeMultiprocessorCount, dev);
        (void)hipFuncSetAttribute((const void*)mk_fwd, hipFuncAttributeMaxDynamicSharedMemorySize, LDS_BYTES);
        (void)hipOccupancyMaxActiveBlocksPerMultiprocessor(&per_cu, (const void*)mk_fwd, 512, LDS_BYTES);
        if (per_cu < 1) per_cu = 1;
        grid = cus * per_cu;
        if (ws_size < WS_SQ + 5 * MiB) { fprintf(stderr, "kernel_launch: workspace too small (%zu < %zu)\n", ws_size, (size_t)PO_END); grid = -1; }
    }
    if (grid < 0) return;
    (void)hipMemsetAsync((char*)d_ws + WS_CTL, 0, 65536, stream);
    Params p{};
    for (int i = 0; i < 24; ++i) p.in[i] = (const float*)d_in[i];
    p.out = (float*)d_out; p.ws = (unsigned char*)d_ws;
    void* args[] = {&p};
    hipError_t e = hipLaunchCooperativeKernel((void*)mk_fwd, dim3(grid), dim3(512), args, LDS_BYTES, stream);
    if (e != hipSuccess) fprintf(stderr, "cooperative launch failed: %s (grid %d)\n", hipGetErrorString(e), grid);
}
```

```cpp
#include <hip/hip_runtime.h>
#include <hip/hip_cooperative_groups.h>
#include <cstdio>
#include <cstdint>
namespace cg = cooperative_groups;

#define DI __device__ __forceinline__
#define LAS __attribute__((address_space(3)))
#define GAS __attribute__((address_space(1)))
typedef unsigned short bf16_t;
typedef short bf16x8 __attribute__((ext_vector_type(8)));
typedef short s16x4 __attribute__((ext_vector_type(4)));
typedef float f32x4 __attribute__((ext_vector_type(4)));
typedef unsigned u32x4 __attribute__((ext_vector_type(4)));
typedef unsigned u32x2 __attribute__((ext_vector_type(2)));

constexpr int D = 1024, NBATCH = 16, SEQ = 4096, CTX = 256, PT = CTX + SEQ  ;
constexpr int HB = 8  , MH = HB * PT  , TPB = PT / 256  ;
constexpr int N_IN = 8960, FFN = 2816, IN_COLS = 8976;
constexpr size_t MiB = 1u << 20;
constexpr size_t WS_CTL = 0, WS_MOD = 1 * MiB, WS_TAB = 2 * MiB, WS_W = 5 * MiB, W_LAYER = 41 * MiB;
constexpr size_t WO_IN = 0, WO_BR = 18 * MiB, WO_OUT = 22 * MiB, WO_UP = 24 * MiB, WO_DN = 35 * MiB;
constexpr size_t WS_XC = 87 * MiB, WS_HN = 103 * MiB, WS_YCAT = 171 * MiB, WS_PROJ = 307 * MiB;
static_assert(WO_DN + (size_t)1024 * 2816 * 2 <= W_LAYER && WS_W + 2 * W_LAYER <= WS_XC, "weight map");
constexpr size_t SZ512 = (size_t)MH * 512 * 2;
constexpr size_t PO_MQ = WS_PROJ, PO_MK = PO_MQ + SZ512, PO_MV = PO_MK + SZ512, PO_MO = PO_MV + SZ512, PO_AQ = PO_MO + SZ512;
constexpr size_t PO_AK = PO_AQ + SZ512, PO_AV = PO_AK + SZ512 / 4, PO_RQ = PO_AV + SZ512 / 4, PO_RK = PO_RQ + SZ512, PO_RV = PO_RK + SZ512;
constexpr size_t PO_RG = PO_RV + 2 * SZ512, PO_G3 = PO_RG + 2 * SZ512, PO_MG = PO_G3 + 6 * SZ512, PO_END = PO_MG + (size_t)MH * 16 * 4;
constexpr size_t PO_MQC = PO_END, PO_MKC = PO_MQC + SZ512, WS_END = PO_MKC + SZ512;
static_assert(WS_END <= 1024 * MiB, "ws size");
constexpr size_t WS_HMB = WS_END, WS_HRB = PO_MQ, WS_END2 = WS_HMB + SZ512;
static_assert(WS_END2 <= 1024 * MiB && PO_MK == PO_MQ + SZ512, "ws size");
constexpr size_t WS_SQ = WS_HMB + SZ512;
static_assert(WS_SQ + (size_t)(MH / 64) * 4 * 1024 * 2 <= 1024 * MiB, "ws size");
constexpr size_t WS_FA = WS_PROJ, WS_FB = WS_FA + (size_t)MH * FFN * 2;
constexpr size_t WS_SA = WS_FA, WS_SB = WS_FA + 16 * MiB;
static_assert((size_t)(MH / 64) * 4 * FFN * 2 <= 16 * MiB && WS_SB + (size_t)(MH / 64) * 2 * FFN * 2 <= WS_FB, "side buffers");
static_assert(PO_END <= 1000 * MiB && WS_FB + (size_t)MH * FFN * 2 <= PO_G3, "ws map");
constexpr int TAB_COSR = 0, TAB_SINR = PT * 64, TAB_COSA = 2 * PT * 64, TAB_SINA = 2 * PT * 64 + 1024;

constexpr int LDS_BYTES = 147456;
#ifndef PH_MASK
#define PH_MASK 0xFFFF
#endif
#define PH(k) if constexpr ((PH_MASK >> (k)) & 1)
#ifndef DUP_MASK
#define DUP_MASK 0
#endif
#define NREP(k) (1 + ((DUP_MASK >> (k)) & 1))
#ifndef PROBE_SEL
#define PROBE_SEL 7
#endif

DI int lv(int x) { asm volatile("" : "+v"(x)); return x; }
DI int ls(int x) { asm volatile("" : "+s"(x)); return x; }
DI float ror1(float v) { return __builtin_bit_cast(float, __builtin_amdgcn_update_dpp(0, __builtin_bit_cast(int, v), 0x121, 0xF, 0xF, false)); }
DI float ror15(float v) { return __builtin_bit_cast(float, __builtin_amdgcn_update_dpp(0, __builtin_bit_cast(int, v), 0x12F, 0xF, 0xF, false)); }
DI float rsum16(float v) {
    v += __builtin_bit_cast(float, __builtin_amdgcn_update_dpp(0, __builtin_bit_cast(int, v), 0x121, 0xF, 0xF, false));
    v += __builtin_bit_cast(float, __builtin_amdgcn_update_dpp(0, __builtin_bit_cast(int, v), 0x122, 0xF, 0xF, false));
    v += __builtin_bit_cast(float, __builtin_amdgcn_update_dpp(0, __builtin_bit_cast(int, v), 0x124, 0xF, 0xF, false));
    v += __builtin_bit_cast(float, __builtin_amdgcn_update_dpp(0, __builtin_bit_cast(int, v), 0x128, 0xF, 0xF, false));
    return v; }
DI unsigned cvt_pk_bf16(float lo, float hi) { unsigned r; asm volatile("v_cvt_pk_bf16_f32 %0, %1, %2" : "=v"(r) : "v"(lo), "v"(hi)); return r; }
DI float bf2f(unsigned short b) { return __uint_as_float(((unsigned)b) << 16); }
DI float bflo(unsigned w) { return __uint_as_float(w << 16); }
DI float bfhi(unsigned w) { return __uint_as_float(w & 0xffff0000u); }
DI float sigmoidf_(float x) { return __builtin_amdgcn_rcpf(1.f + __expf(-x)); }
DI float siluf_(float x) { return x * sigmoidf_(x); }
DI float logsigmoidf_(float x) { return fminf(x, 0.f) - __logf(1.f + __expf(-fabsf(x))); }
DI u32x2 pack4(f32x4 v) { u32x2 w; w.x = cvt_pk_bf16(v[0], v[1]); w.y = cvt_pk_bf16(v[2], v[3]); return w; }
DI f32x4 unpack4(u32x2 w) { return (f32x4){bflo(w.x), bfhi(w.x), bflo(w.y), bfhi(w.y)}; }

namespace pg8 {
constexpr int BM = 256, BK = 64, HALF = 128, HTB = HALF * BK * 2, STAGE_BYTES = 8 * HTB, NXCD = 8, WGM = 4;
__host__ __device__ __forceinline__ int lds_byte(int r, int c) { const int st = (r >> 4) * 2 + (c >> 5), rr = r & 15, cc = c & 31, ob = rr * 64 + cc * 2; return st * 1024 + (ob ^ (((ob >> 9) & 1) << 5)); }
__host__ __device__ __forceinline__ void stage_rc(int b, int& R, int& C) { const int st = b / 1024, sb = b % 1024, swz = sb ^ (((sb >> 9) & 1) << 5); R = (st >> 1) * 16 + swz / 64; C = (st & 1) * 32 + (swz % 64) / 2; }
__host__ __device__ __forceinline__ int perm32(int rho) { const int n = rho >> 4, i = rho & 15; return 8 * (i >> 2) + 4 * n + (i & 3); }
struct Unit { int pm, pn, br; };
struct StaticOrder {
    int nM, nN, nwg, G, c, lat;
    DI void init(int M, int N, int G_, int c_, int lat_ = 0) { lat = lat_; nM = lat_ ? HB * 16 : M / BM; nN = N / BM; nwg = nM * nN; G = G_; c = c_; }
    DI bool next(int i, Unit& u) const {
        const long L = (long)i * G + c; if (L >= nwg) return false;
        int wgid = (int)L; { const int q = nwg / NXCD, r = nwg % NXCD, xcd = wgid % NXCD, off = wgid / NXCD; wgid = (xcd < r ? xcd * (q + 1) : r * (q + 1) + (xcd - r) * q) + off; }
        const int nig = WGM * nN, gid = wgid / nig, fm = gid * WGM, gsz = (nM - fm) < WGM ? (nM - fm) : WGM;
        u.pm = fm + ((wgid % nig) % gsz); u.pn = (wgid % nig) / gsz; u.br = 0; if (lat) u.pm = (u.pm >> 4) * TPB + 1 + (u.pm & 15); return true;
    }
};
struct Sched1 {
    StaticOrder o; const char* A; const char* B; size_t tsA, tsB; int nt;
    DI bool next(int i, Unit& u) const { return o.next(i, u); }
    DI void locate(const Unit& u, const char*& a, const char*& b, int& n) const { a = A + (size_t)u.pm * tsA; b = B + (size_t)u.pn * tsB; n = nt; }
};
struct SchedInLast {
    StaticOrder o; const char* A; const char* B; size_t tsA, tsB; int nt;
    DI bool next(int i, Unit& u) const {
        const long L = (long)i * o.G + o.c;
        if (L < o.nwg) return o.next(i, u);
        const int e = (int)(L - o.nwg); if (e >= HB * 11) return false;
        const int bl = e / 11, k = e - bl * 11;
        u.pm = bl * TPB; u.pn = k < 4 ? 2 + k : (k == 4 ? 10 : 8 + k); u.br = 0; return true;
    }
    DI void locate(const Unit& u, const char*& a, const char*& b, int& n) const { a = A + (size_t)u.pm * tsA; b = B + (size_t)u.pn * tsB; n = nt; }
};
struct Sched3 {
    StaticOrder o; const char* A; const char* B; size_t tsA, tsB;
    DI bool next(int i, Unit& u) const { const int j = i / 3; if (!o.next(j, u)) return false; u.br = i - 3 * j; return true; }
    DI void locate(const Unit& u, const char*& a, const char*& b, int& n) const {
        const int koff = u.br == 0 ? 0 : (u.br == 1 ? 512 : 1024);
        a = A + (size_t)u.pm * tsA + koff * 2; b = B + (size_t)u.pn * tsB + koff * 2; n = u.br == 2 ? 16 : 8; }
};

template <class Epi, class Sched>
DI void gemm_phase(LAS unsigned char* lds, int lda, int ldb, const Sched& S, const Epi& E) {
    const int tid = lv(threadIdx.x), wid = __builtin_amdgcn_readfirstlane(tid >> 6), lane = tid & 63, wr = wid >> 2, wc = wid & 3, fr = lane & 15, fq = lane >> 4;
    unsigned voffA[2], voffB[2];
#pragma unroll
    for (int i = 0; i < 2; ++i) { int R, C; stage_rc(tid * 16 + i * 8192, R, C); const int Rb = Epi::PERM ? ((R & ~31) + perm32(R & 31)) : R; voffA[i] = (unsigned)(R * lda + C) * 2u; voffB[i] = (unsigned)(Rb * ldb + C) * 2u; }
    const size_t kstep = (size_t)(BK * 2);
    const size_t hsA = (size_t)HALF * lda * 2, hsB = (size_t)HALF * ldb * 2;
    const unsigned ldsw = (unsigned)wid * 1024u;
    const int aoff = lds_byte(wr * 64 + fr, fq * 8), boff = lds_byte(wc * 32 + fr, fq * 8);
#define PG8_SA(b, h) (((b) * 2 + (h)) * HTB)
#define PG8_SB(b, h) ((4 + (b) * 2 + (h)) * HTB)
#define PG8_STAGE(bufoff, gbase, voff) do { _Pragma("unroll") for (int _i = 0; _i < 2; ++_i) \
        __builtin_amdgcn_global_load_lds((const unsigned*)((const char*)(gbase) + (voff)[_i]), (LAS unsigned*)(lds + (bufoff) + ldsw + _i * 8192), 16, 0, 0); } while (0)
#define PG8_LDA(dst, b, h) do { _Pragma("unroll") for (int m = 0; m < 4; ++m) _Pragma("unroll") for (int k = 0; k < 2; ++k) dst[m][k] = *(const LAS bf16x8*)(lds + PG8_SA(b, h) + aoff + m * 2048 + k * 1024); } while (0)
#define PG8_LDB(dst, b, h) do { _Pragma("unroll") for (int n = 0; n < 2; ++n) _Pragma("unroll") for (int k = 0; k < 2; ++k) dst[n][k] = *(const LAS bf16x8*)(lds + PG8_SB(b, h) + boff + n * 2048 + k * 1024); } while (0)
#define PG8_MMA(ai, bj, At, Bt) do { __builtin_amdgcn_s_setprio(1); _Pragma("unroll") for (int m = 0; m < 4; ++m) _Pragma("unroll") for (int n = 0; n < 2; ++n) _Pragma("unroll") for (int k = 0; k < 2; ++k) \
        acc[ai][bj][m][n] = __builtin_amdgcn_mfma_f32_16x16x32_bf16(Bt[n][k], At[m][k], acc[ai][bj][m][n], 0, 0, 0); __builtin_amdgcn_s_setprio(0); } while (0)
#define PG8_WAIT_V(n) asm volatile("s_waitcnt vmcnt(" #n ")" ::: "memory")
#define PG8_WAIT_L(n) asm volatile("s_waitcnt lgkmcnt(" #n ")" ::: "memory")
#define PG8_BAR __builtin_amdgcn_s_barrier()
#define PG8_SCHED __builtin_amdgcn_sched_barrier(0)
    Unit cur, nxt; int ui = 0;
    if (!S.next(0, cur)) return;
    f32x4 acc[2][2][4][2];
#pragma unroll
    for (int a = 0; a < 2; ++a)
#pragma unroll
        for (int b = 0; b < 2; ++b)
#pragma unroll
            for (int m = 0; m < 4; ++m)
#pragma unroll
                for (int n = 0; n < 2; ++n) acc[a][b][m][n] = (f32x4){0.f, 0.f, 0.f, 0.f};
    bf16x8 At[4][2], B0[2][2], B1[2][2];
    const char* cA; const char* cB; int nt; S.locate(cur, cA, cB, nt);
    PG8_STAGE(PG8_SB(0, 0), cB, voffB); PG8_STAGE(PG8_SB(0, 1), cB + hsB, voffB); PG8_STAGE(PG8_SA(0, 0), cA, voffA); PG8_STAGE(PG8_SA(0, 1), cA + hsA, voffA);
    if (wr == 1) PG8_BAR;
    PG8_WAIT_V(2); PG8_BAR;
    PG8_STAGE(PG8_SB(1, 0), cB + kstep, voffB); PG8_STAGE(PG8_SA(1, 0), cA + kstep, voffA); PG8_STAGE(PG8_SB(1, 1), cB + hsB + kstep, voffB);
    PG8_WAIT_V(6); PG8_BAR;
    for (;;) {
        const bool has_next = S.next(ui + 1, nxt);
        const char* nA = cA; const char* nB = cB; int nnt = nt;
        if (has_next) S.locate(nxt, nA, nB, nnt);
        for (int t = 0; t < nt; t += 2) {
            const bool last = (t == nt - 2);
            const char* a1 = cA + (size_t)(t + 1) * kstep;
            const char* a2 = last ? nA : cA + (size_t)(t + 2) * kstep; const char* b2 = last ? nB : cB + (size_t)(t + 2) * kstep;
            const char* a3 = a2 + kstep; const char* b3 = b2 + kstep;
            PG8_LDB(B0, 0, 0); PG8_LDB(B1, 0, 1); PG8_SCHED; PG8_LDA(At, 0, 0); PG8_STAGE(PG8_SA(1, 1), a1 + hsA, voffA);
            PG8_WAIT_V(8); PG8_WAIT_L(0); PG8_BAR; PG8_MMA(0, 0, At, B0); PG8_MMA(0, 1, At, B1); PG8_BAR; PG8_SCHED;
            PG8_LDA(At, 0, 1); PG8_STAGE(PG8_SB(0, 0), b2, voffB); PG8_STAGE(PG8_SB(0, 1), b2 + hsB, voffB); PG8_STAGE(PG8_SA(0, 0), a2, voffA);
            PG8_WAIT_V(8); PG8_WAIT_L(0); PG8_BAR; PG8_MMA(1, 0, At, B0); PG8_MMA(1, 1, At, B1); PG8_BAR; PG8_SCHED;
            PG8_LDB(B0, 1, 0); PG8_LDB(B1, 1, 1); PG8_SCHED; PG8_LDA(At, 1, 0); PG8_STAGE(PG8_SA(0, 1), a2 + hsA, voffA);
            PG8_WAIT_V(8); PG8_WAIT_L(0); PG8_BAR; PG8_MMA(0, 0, At, B0); PG8_MMA(0, 1, At, B1); PG8_BAR; PG8_SCHED;
            PG8_LDA(At, 1, 1); PG8_STAGE(PG8_SB(1, 0), b3, voffB); PG8_STAGE(PG8_SB(1, 1), b3 + hsB, voffB); PG8_STAGE(PG8_SA(1, 0), a3, voffA);
            PG8_WAIT_V(8); PG8_WAIT_L(0); PG8_BAR; PG8_MMA(1, 0, At, B0); PG8_MMA(1, 1, At, B1); PG8_BAR; PG8_SCHED;
        }
        if (wr == 0) PG8_BAR;
        E(acc, cur, wr, wc, fr, fq);
        if (!has_next) break;
#pragma unroll
        for (int a = 0; a < 2; ++a)
#pragma unroll
            for (int b = 0; b < 2; ++b)
#pragma unroll
                for (int m = 0; m < 4; ++m)
#pragma unroll
                    for (int n = 0; n < 2; ++n) acc[a][b][m][n] = (f32x4){0.f, 0.f, 0.f, 0.f};
        cur = nxt; cA = nA; cB = nB; nt = nnt; ++ui;
        if (wr == 1) PG8_BAR;
    }
    PG8_WAIT_V(0);
    PG8_BAR;
#undef PG8_SA
#undef PG8_SB
#undef PG8_STAGE
#undef PG8_LDA
#undef PG8_LDB
#undef PG8_MMA
#undef PG8_WAIT_V
#undef PG8_WAIT_L
#undef PG8_BAR
#undef PG8_SCHED
}
}
using pg8::Unit;

typedef f32x4 Acc[2][2][4][2];

struct EpiIn {
    static constexpr bool PERM = true;
    unsigned char* ws; const float* tab; const float* mcw;
    DI void conv_tile(const Acc& acc, const Unit& u, int wr, int wc, int fr, int fq) const {
        const int which = u.pn >> 1;
        bf16_t* dst = (bf16_t*)(ws + (which ? PO_MKC : PO_MQC)); bf16_t* SQ = (bf16_t*)(ws + WS_SQ);
        const float sc = which ? 0.08838834764831845f : 1.f;
#pragma unroll
        for (int bj = 0; bj < 2; ++bj) {
            const int c0 = (u.pn & 1) * 256 + bj * 128 + wc * 32 + fq * 8;
            f32x4 w0[2], w1[2], w2[2];
#pragma unroll
            for (int n = 0; n < 2; ++n) { const float* cw = mcw + which * 512 + c0 + 4 * n; w0[n] = *(const GAS f32x4*)cw; w1[n] = *(const GAS f32x4*)(cw + 1024); w2[n] = *(const GAS f32x4*)(cw + 2048); }
#pragma unroll
            for (int ai = 0; ai < 2; ++ai) {
                const size_t rb = (size_t)u.pm * 256 + ai * 128 + wr * 64; const size_t blk = rb >> 6;
                f32x4 rprev[2], lcur[2];
#pragma unroll
                for (int n = 0; n < 2; ++n)
#pragma unroll
                    for (int e = 0; e < 4; ++e) { rprev[n][e] = 0.f; lcur[n][e] = ror15(acc[ai][bj][0][n][e]); }
#pragma unroll
                for (int m = 0; m < 4; ++m) {
                    u32x2 pk[2];
#pragma unroll
                    for (int n = 0; n < 2; ++n) {
                        const f32x4 a = acc[ai][bj][m][n];
                        f32x4 rcur, lnext, o;
#pragma unroll
                        for (int e = 0; e < 4; ++e) { rcur[e] = ror1(a[e]); lnext[e] = m < 3 ? ror15(acc[ai][bj][m < 3 ? m + 1 : 3][n][e]) : 0.f; }
#pragma unroll
                        for (int e = 0; e < 4; ++e) { const float pv = fr > 0 ? rcur[e] : rprev[n][e], nx = fr < 15 ? lcur[n][e] : lnext[e];
                            o[e] = siluf_(w0[n][e] * pv + w1[n][e] * a[e] + w2[n][e] * nx) * sc; }
                        pk[n] = pack4(o); rprev[n] = rcur; lcur[n] = lnext;
                    }
                    const bool edge = (m == 0 && fr == 0) || (m == 3 && fr == 15);
                    if (!edge) *(GAS u32x4*)(dst + (rb + 16 * m + fr) * 512 + c0) = (u32x4){pk[0].x, pk[0].y, pk[1].x, pk[1].y};
                    if ((m == 0 && fr < 2) || (m == 3 && fr >= 14)) {
                        const int slot = m == 0 ? fr : fr - 12;
                        const u32x2 a0 = pack4(acc[ai][bj][m][0]), a1 = pack4(acc[ai][bj][m][1]);
                        *(GAS u32x4*)(SQ + (blk * 4 + slot) * 1024 + which * 512 + c0) = (u32x4){a0.x, a0.y, a1.x, a1.y};
                    }
                }
            }
        }
    }
    DI void operator()(const Acc& acc, const Unit& u, int wr, int wc, int fr, int fq) const {
        fr = lv(fr); fq = lv(fq); wr = ls(wr); wc = ls(wc);
        const int pn = u.pn, jt = u.pm % TPB; const bool is_ctx = (jt == 0);
        if (pn < 4) { conv_tile(acc, u, wr, wc, fr, fq); return; }
#pragma unroll
        for (int bj = 0; bj < 2; ++bj) {
            size_t off; int ld, col, act; float scale = 1.f;
            if (pn < 2) { off = PO_MQ; ld = 512; col = pn * 256; act = 0; }
            else if (pn < 4) { off = PO_MK; ld = 512; col = (pn - 2) * 256; act = 0; }
            else if (pn < 6) { off = PO_MV; ld = 512; col = (pn - 4) * 256; act = 0; }
            else if (pn < 8) { off = PO_MO; ld = 512; col = (pn - 6) * 256; act = 1; }
            else if (pn < 10) { off = PO_AQ; ld = 512; col = (pn - 8) * 256; act = 3; scale = 0.125f * 1.4426950408889634f; }
            else if (pn == 10) { if (bj == 0) { off = PO_AK; ld = 128; col = -128 * bj; act = 3; } else { off = PO_AV; ld = 128; col = -128; act = 0; } }
            else if (pn < 13) { off = PO_RQ; ld = 512; col = (pn - 11) * 256; act = 4; }
            else if (pn < 15) { off = PO_RK; ld = 512; col = (pn - 13) * 256; act = 4; scale = 0.08838834764831845f; }
            else if (pn < 19) { off = PO_RV; ld = 1024; col = (pn - 15) * 256; act = 0; }
            else if (pn < 23) { off = PO_RG; ld = 1024; col = (pn - 19) * 256; act = 2; }
            else { off = PO_G3; ld = 3072; col = (pn - 23) * 256; act = 1; }
            bf16_t* dst = (bf16_t*)(ws + off);
            const int c0 = col + bj * 128 + wc * 32 + fq * 8;
#pragma unroll
            for (int ai = 0; ai < 2; ++ai)
#pragma unroll
                for (int m = 0; m < 4; ++m) {
                    const int rit = ai * 128 + wr * 64 + m * 16 + fr;
                    const size_t r = (size_t)u.pm * 256 + rit;
                    f32x4 v0 = acc[ai][bj][m][0], v1 = acc[ai][bj][m][1];
                    if (act == 1) {
#pragma unroll
                        for (int e = 0; e < 4; ++e) { v0[e] = sigmoidf_(v0[e]); v1[e] = sigmoidf_(v1[e]); }
                    } else if (act == 2) {
#pragma unroll
                        for (int e = 0; e < 4; ++e) { v0[e] = siluf_(v0[e]); v1[e] = siluf_(v1[e]); }
                    } else if (act == 3) {
                        if (!is_ctx) {
                            const int t = (jt - 1) * 256 + rit; const int posv = (wc & 1) ? (t & 63) : (t >> 6);
                            const f32x4 cs = *(const GAS f32x4*)(tab + TAB_COSA + posv * 16 + fq * 4), sn = *(const GAS f32x4*)(tab + TAB_SINA + posv * 16 + fq * 4);
                            const f32x4 a = v0 * cs - v1 * sn, b = v0 * sn + v1 * cs; v0 = a; v1 = b;
                        }
                        v0 = v0 * scale; v1 = v1 * scale;
                    } else if (act == 4) {
                        const int p = jt * 256 + rit;
                        const f32x4 cs = *(const GAS f32x4*)(tab + TAB_COSR + p * 64 + wc * 16 + fq * 4), sn = *(const GAS f32x4*)(tab + TAB_SINR + p * 64 + wc * 16 + fq * 4);
                        const f32x4 a = v0 * cs - v1 * sn, b = v0 * sn + v1 * cs; v0 = a * scale; v1 = b * scale;
                    }
                    bf16_t* rp = dst + r * ld + c0;
                    { const u32x2 p0 = pack4(v0), p1 = pack4(v1); *(GAS u32x4*)rp = (u32x4){p0.x, p0.y, p1.x, p1.y}; }
                    asm volatile("" ::: "memory");
                }
        }
    }
};
struct EpiBr {
    static constexpr bool PERM = true;
    bf16_t* Z; const bf16_t* G3;
    DI void operator()(const Acc& acc, const Unit& u, int wr, int wc, int fr, int fq) const {
        fr = lv(fr); fq = lv(fq); wr = ls(wr); wc = ls(wc);
        const int br = u.br;
#pragma unroll
        for (int ai = 0; ai < 2; ++ai) {
            u32x4 gw[4][2], zo[4][2];
#pragma unroll
            for (int m = 0; m < 4; ++m) {
                const size_t r = (size_t)u.pm * 256 + ai * 128 + wr * 64 + m * 16 + fr;
#pragma unroll
                for (int bj = 0; bj < 2; ++bj) {
                    const int c = u.pn * 256 + bj * 128 + wc * 32 + fq * 8;
                    gw[m][bj] = *(const GAS u32x4*)(G3 + r * 3072 + br * 1024 + c);
                    if (br > 0) zo[m][bj] = *(const GAS u32x4*)(Z + r * 1024 + c);
                }
            }
            __builtin_amdgcn_sched_barrier(0);
#pragma unroll
            for (int m = 0; m < 4; ++m) {
                const size_t r = (size_t)u.pm * 256 + ai * 128 + wr * 64 + m * 16 + fr;
#pragma unroll
                for (int bj = 0; bj < 2; ++bj) {
                    const int c = u.pn * 256 + bj * 128 + wc * 32 + fq * 8;
                    const u32x4 g4 = gw[m][bj];
                    f32x4 z0 = unpack4((u32x2){g4.x, g4.y}) * acc[ai][bj][m][0], z1 = unpack4((u32x2){g4.z, g4.w}) * acc[ai][bj][m][1];
                    if (br > 0) { const u32x4 z4 = zo[m][bj]; z0 = z0 + unpack4((u32x2){z4.x, z4.y}); z1 = z1 + unpack4((u32x2){z4.z, z4.w}); }
                    const u32x2 p0 = pack4(z0), p1 = pack4(z1);
                    *(GAS u32x4*)(Z + r * 1024 + c) = (u32x4){p0.x, p0.y, p1.x, p1.y};
                }
            }
            __builtin_amdgcn_sched_barrier(0);
        }
    }
};
struct EpiRes {
    static constexpr bool PERM = true;
    const float* x_in; const float* ctx_in; float* out; float* xc; const float* gate; int half, first, skip_ctx;
    DI void operator()(const Acc& acc, const Unit& u, int wr, int wc, int fr, int fq) const {
        fr = lv(fr); fq = lv(fq); wr = ls(wr); wc = ls(wc);
        const int bl = u.pm / TPB, jt = u.pm - bl * TPB, b = half * HB + bl; const bool is_ctx = (jt == 0);
        if (is_ctx && skip_ctx) return;
        const float* gr = gate + (size_t)(is_ctx ? 16 : b) * 6144;
        f32x4 g[2][2];
#pragma unroll
        for (int bj = 0; bj < 2; ++bj)
#pragma unroll
            for (int n = 0; n < 2; ++n) g[bj][n] = *(const GAS f32x4*)(gr + u.pn * 256 + bj * 128 + wc * 32 + fq * 8 + n * 4);
        float* const dbase = is_ctx ? xc : out;
        const float* const bbase = first ? (is_ctx ? ctx_in : x_in) : (const float*)dbase;
        const size_t rbase0 = is_ctx ? (size_t)b * CTX : (size_t)b * SEQ + (jt - 1) * 256;
#pragma unroll
        for (int ai = 0; ai < 2; ++ai)
#pragma unroll
        for (int mh = 0; mh < 2; ++mh) {
            f32x4 xs[2][2][2];
#pragma unroll
            for (int m2 = 0; m2 < 2; ++m2) {
                const int rit = ai * 128 + wr * 64 + (mh * 2 + m2) * 16 + fr;
                const float* bp = bbase + (rbase0 + rit) * D;
#pragma unroll
                for (int bj = 0; bj < 2; ++bj)
#pragma unroll
                    for (int n = 0; n < 2; ++n) xs[m2][bj][n] = *(const GAS f32x4*)(bp + u.pn * 256 + bj * 128 + wc * 32 + fq * 8 + n * 4);
            }
            __builtin_amdgcn_sched_barrier(0);
#pragma unroll
            for (int m2 = 0; m2 < 2; ++m2) {
                const int m = mh * 2 + m2;
                const int rit = ai * 128 + wr * 64 + m * 16 + fr;
                float* dp = dbase + (rbase0 + rit) * D;
#pragma unroll
                for (int bj = 0; bj < 2; ++bj)
#pragma unroll
                    for (int n = 0; n < 2; ++n) *(GAS f32x4*)(dp + u.pn * 256 + bj * 128 + wc * 32 + fq * 8 + n * 4) = xs[m2][bj][n] + g[bj][n] * acc[ai][bj][m][n];
            }
            __builtin_amdgcn_sched_barrier(0);
        }
    }
};
struct EpiUp {
    static constexpr bool PERM = true;
    bf16_t* U; bf16_t* SA; bf16_t* SB; const float* cw; const float* cb;
    DI void operator()(const Acc& acc, const Unit& u, int wr, int wc, int fr, int fq) const {
        fr = lv(fr); fq = lv(fq); wr = ls(wr); wc = ls(wc);
        const int lane = fq * 16 + fr, c0 = u.pn * 128 + wc * 32 + fq * 8;
        f32x4 w0[2], w1[2], w2[2], bs[2];
#pragma unroll
        for (int n = 0; n < 2; ++n) { w0[n] = *(const GAS f32x4*)(cw + c0 + 4 * n); w1[n] = *(const GAS f32x4*)(cw + FFN + c0 + 4 * n); w2[n] = *(const GAS f32x4*)(cw + 2 * FFN + c0 + 4 * n); bs[n] = *(const GAS f32x4*)(cb + c0 + 4 * n); }
#pragma unroll
        for (int ai = 0; ai < 2; ++ai) {
            const size_t rb = (size_t)u.pm * 256 + ai * 128 + wr * 64;
            const size_t blk = rb >> 6;
            f32x4 rprev[2], lcur[2];
#pragma unroll
            for (int n = 0; n < 2; ++n)
#pragma unroll
                for (int e = 0; e < 4; ++e) { rprev[n][e] = 0.f; lcur[n][e] = ror15(acc[ai][0][0][n][e]); }
#pragma unroll
            for (int m = 0; m < 4; ++m) {
                u32x2 pk[2];
#pragma unroll
                for (int n = 0; n < 2; ++n) {
                    const f32x4 a = acc[ai][0][m][n], b = acc[ai][1][m][n];
                    f32x4 rcur, lnext;
#pragma unroll
                    for (int e = 0; e < 4; ++e) { rcur[e] = ror1(a[e]); lnext[e] = m < 3 ? ror15(acc[ai][0][m < 3 ? m + 1 : 3][n][e]) : 0.f; }
                    f32x4 o;
#pragma unroll
                    for (int e = 0; e < 4; ++e) {
                        const float pv = fr > 0 ? rcur[e] : rprev[n][e], nx = fr < 15 ? lcur[n][e] : lnext[e];
                        o[e] = siluf_(w0[n][e] * pv + w1[n][e] * a[e] + w2[n][e] * nx + bs[n][e]) * b[e];
                    }
                    pk[n] = pack4(o);
                    rprev[n] = rcur; lcur[n] = lnext;
                }
                const bool edge = (m == 0 && fr == 0) || (m == 3 && fr == 15);
                if (!edge) *(GAS u32x4*)(U + (rb + 16 * m + fr) * FFN + c0) = (u32x4){pk[0].x, pk[0].y, pk[1].x, pk[1].y};
                if (m == 0 || m == 3) {
                    const int slot = m == 0 ? fr : fr - 12;
                    if (slot >= 0 && slot < 4 && (m == 0 ? fr < 2 : fr >= 14)) {
                        const u32x2 a0 = pack4(acc[ai][0][m][0]), a1 = pack4(acc[ai][0][m][1]);
                        *(GAS u32x4*)(SA + (blk * 4 + slot) * FFN + c0) = (u32x4){a0.x, a0.y, a1.x, a1.y};
                        if (edge) { const u32x2 b0 = pack4(acc[ai][1][m][0]), b1 = pack4(acc[ai][1][m][1]);
                            *(GAS u32x4*)(SB + (blk * 2 + (m == 3)) * FFN + c0) = (u32x4){b0.x, b0.y, b1.x, b1.y}; }
                    }
                }
            }
        }
    }
};
struct MixArgs { unsigned char* ws; const float* conv_w; const float* sink; const float* ret_logit; int need_ctx; };
DI bf16x8 ldfrag(const LAS unsigned char* p) { return *(const LAS bf16x8*)p; }
DI bf16x8 trfrag(const LAS unsigned char* p, int off2) {
    const s16x4 a = __builtin_amdgcn_ds_read_tr16_b64_v4i16((LAS s16x4*)p);
    const s16x4 b = __builtin_amdgcn_ds_read_tr16_b64_v4i16((LAS s16x4*)(p + off2));
    return (bf16x8){a[0], a[1], a[2], a[3], b[0], b[1], b[2], b[3]};
}
DI bf16x8 pack8(f32x4 a, f32x4 b) { u32x4 w; w.x = cvt_pk_bf16(a[0], a[1]); w.y = cvt_pk_bf16(a[2], a[3]); w.z = cvt_pk_bf16(b[0], b[1]); w.w = cvt_pk_bf16(b[2], b[3]); return __builtin_bit_cast(bf16x8, w); }
#define MFMA16(a, b, c) __builtin_amdgcn_mfma_f32_16x16x32_bf16(a, b, c, 0, 0, 0)

constexpr int LROW = 288, BROW = 272;

constexpr int L_QS = 0, L_KS = 17408, L_KWS = 34816, L_VS = 53248, L_CS = 71680, L_SC = 110848;
template <bool ML>
DI void linattn_unit(LAS unsigned char* lds, const MixArgs& A, int bl, int h, int vs, int dir) {
    const int tid = lv(threadIdx.x), wid = __builtin_amdgcn_readfirstlane(tid >> 6), lane = tid & 63, li = lane & 15, qq = lane >> 4;
    constexpr int NVT = ML ? 9 : 8, NX = ML ? 5 : 4;
    const GAS bf16_t* Qg = (const GAS bf16_t*)(A.ws + (ML ? PO_MQC : PO_RQ)) + h * 128;
    const GAS bf16_t* Kg = (const GAS bf16_t*)(A.ws + (ML ? PO_MKC : PO_RK)) + h * 128;
    const int ldv = ML ? 512 : 1024;
    const GAS bf16_t* Vg = (const GAS bf16_t*)(A.ws + (ML ? PO_MV : PO_RV)) + (ML ? h * 128 : h * 256 + vs * 128);
    GAS bf16_t* Og; int ldo;
    if (dir == 0) { Og = (GAS bf16_t*)(A.ws + WS_YCAT) + (ML ? h * 128 : 1024 + h * 256 + vs * 128); ldo = 2048; }
    else if (ML) { Og = (GAS bf16_t*)(A.ws + WS_HMB) + h * 128; ldo = 512; }
    else { Og = (GAS bf16_t*)(A.ws + WS_HRB) + h * 256 + vs * 128; ldo = 1024; }
    const GAS float* MGg = (const GAS float*)(A.ws + PO_MG);
    const size_t row0 = (size_t)bl * PT;
    LAS float* sbm = (LAS float*)(lds + L_SC) + wid * 384; LAS float* su = sbm + 64; LAS float* siw = sbm + 128; LAS float* sw = sbm + 192; LAS float* sem = sbm + 256;
    const int sgq = tid & 15;
    __syncthreads();
    if (ML) {
        if (tid < 64) { LAS unsigned* vp = (LAS unsigned*)(lds + L_VS + tid * LROW + 256); const unsigned zz = (unsigned)lv(0);
#pragma unroll
            for (int e = 0; e < 8; ++e) vp[e] = e == 0 ? (zz | 0x3F80u) : zz; }
    }
    {
        f32x4 cacc[NVT];
#pragma unroll
        for (int t = 0; t < NVT; ++t) cacc[t] = (f32x4){0.f, 0.f, 0.f, 0.f};
        for (int i = tid; i < NVT * 16 * (BROW / 4); i += 512) ((LAS unsigned*)(lds + L_CS))[i] = 0u;
        float m_run = 0.f;
        const float lg = ML ? 0.f : logsigmoidf_(A.ret_logit[dir * 4 + h]);
        u32x4 pq[2], pk[2], pvv[2]; float plf = lg, plii = 0.f;
#define LA_LOAD(CI) do { const int mc_ = dir == 0 ? (CI) : ((CI) < 4 ? 3 - (CI) : 71 - (CI)), p0_ = mc_ * 64; const size_t rb_ = row0 + p0_; \
            if (ML) { const GAS float* g_ = MGg + (rb_ + lane) * 16; plf = g_[(dir ? 12 : 4) + h]; plii = g_[(dir ? 8 : 0) + h]; } \
            _Pragma("unroll") for (int it_ = 0; it_ < 2; ++it_) { const int i_ = (tid + it_ * 512) >> 4; pq[it_] = *(const GAS u32x4*)(Qg + (rb_ + i_) * 512 + sgq * 8); pk[it_] = *(const GAS u32x4*)(Kg + (rb_ + i_) * 512 + sgq * 8); \
                pvv[it_] = *(const GAS u32x4*)(Vg + (rb_ + i_) * ldv + sgq * 8); } } while (0)
        LA_LOAD(0);
        for (int ci = 0; ci < 68; ++ci) {
            const int mc = dir == 0 ? ci : (ci < 4 ? 3 - ci : 71 - ci), p0 = mc * 64;
            const size_t rbase = row0 + p0;
            float decay;
            {
                float b, u, g, cml = 0.f, cm = 0.f;
                if (ML) {
                    const float lf = plf, lii = plii;
                    b = lf;
                    if (dir == 0) {
#pragma unroll
                        for (int o = 1; o < 64; o <<= 1) { const float t = __shfl_up(b, o); if (lane >= o) b += t; }
                    } else {
#pragma unroll
                        for (int o = 1; o < 64; o <<= 1) { const float t = __shfl_down(b, o); if (lane + o < 64) b += t; }
                    }
                    u = lii - b; cm = u;
                    if (dir == 0) {
#pragma unroll
                        for (int o = 1; o < 64; o <<= 1) { const float t = __shfl_up(cm, o); if (lane >= o) cm = fmaxf(cm, t); }
                    } else {
#pragma unroll
                        for (int o = 1; o < 64; o <<= 1) { const float t = __shfl_down(cm, o); if (lane + o < 64) cm = fmaxf(cm, t); }
                    }
                    g = __shfl(b, dir ? 0 : 63); cml = __shfl(cm, dir ? 0 : 63);
                } else {
                    b = (float)(dir ? 64 - lane : lane + 1) * lg; u = -b; g = 64.f * lg;
                }
                float bm, iw, w, em, m_new;
                if (ML) { const float mj = b + fmaxf(m_run, cm); iw = __expf(b + m_run - mj); m_new = g + fmaxf(m_run, cml); w = __expf(g + u - m_new); decay = __expf(g + m_run - m_new); em = __expf(-mj); bm = b - mj; }
                else { bm = b; iw = __expf(b); w = __expf(g + u); decay = __expf(g); em = 1.f; m_new = 0.f; }
                sbm[lane] = bm; su[lane] = u; siw[lane] = iw; sw[lane] = w; sem[lane] = em;
                m_run = m_new;
            }
#pragma unroll
            for (int it = 0; it < 2; ++it) {
                const int idx = tid + it * 512, i = idx >> 4, sg = sgq; const float wi = sw[i];
                const u32x4 ko = pk[it]; u32x4 kwo;
#pragma unroll
                for (int e = 0; e < 4; ++e) kwo[e] = cvt_pk_bf16(bflo(ko[e]) * wi, bfhi(ko[e]) * wi);
                *(LAS u32x4*)(lds + L_QS + i * BROW + sg * 16) = pq[it]; *(LAS u32x4*)(lds + L_KS + i * BROW + sg * 16) = ko; *(LAS u32x4*)(lds + L_KWS + i * LROW + sg * 16) = kwo;
                *(LAS u32x4*)(lds + L_VS + i * LROW + sg * 16) = pvv[it];
            }
            if (ci + 1 < 68) LA_LOAD(ci + 1);
            __syncthreads();
            {
                const int jt = wid & 3, dg = wid >> 2, j = 16 * jt + li;
                bf16x8 qf[4];
#pragma unroll
                for (int ks = 0; ks < 4; ++ks) qf[ks] = ldfrag(lds + L_QS + j * BROW + (32 * ks + 8 * qq) * 2);
                f32x4 s[4];
#pragma unroll
                for (int rt = 0; rt < 4; ++rt) { s[rt] = (f32x4){0.f, 0.f, 0.f, 0.f};
#pragma unroll
                    for (int ks = 0; ks < 4; ++ks) s[rt] = MFMA16(ldfrag(lds + L_KS + (16 * rt + li) * BROW + (32 * ks + 8 * qq) * 2), qf[ks], s[rt]); }
                const float bmj = sbm[j];
#pragma unroll
                for (int rt = 0; rt < 4; ++rt) { const f32x4 u4 = *(const LAS f32x4*)(su + 16 * rt + 4 * qq);
#pragma unroll
                    for (int e = 0; e < 4; ++e) { const int r = 16 * rt + 4 * qq + e; const bool ok = dir ? (r >= j) : (r <= j); s[rt][e] = ok ? s[rt][e] * __expf(bmj + u4[e]) : 0.f; } }
                bf16x8 pf[2];
                pf[0] = pack8(s[0], s[1]); pf[1] = pack8(s[2], s[3]);
                f32x4 o[NX];
                const float iw = siw[j];
#pragma unroll
                for (int x = 0; x < NX; ++x) {
                    const int dvt = x < 4 ? 4 * dg + x : 8;
                    f32x4 oo = (f32x4){0.f, 0.f, 0.f, 0.f}, itr = oo;
#pragma unroll
                    for (int kk = 0; kk < 2; ++kk) oo = MFMA16(trfrag(lds + L_VS + (32 * kk + 4 * qq + (li >> 2)) * LROW + (16 * dvt + 4 * (li & 3)) * 2, 16 * LROW), pf[kk], oo);
#pragma unroll
                    for (int ks = 0; ks < 4; ++ks) itr = MFMA16(ldfrag(lds + L_CS + (16 * dvt + li) * BROW + (32 * ks + 8 * qq) * 2), qf[ks], itr);
                    o[x] = oo + itr * iw;
                }
                if (ML) {
                    const float den = __shfl(o[NX - 1][0], li);
                    const float inv = __builtin_amdgcn_rcpf(fmaxf(fabsf(den), sem[j]));
#pragma unroll
                    for (int x = 0; x < 4; ++x) o[x] = o[x] * inv;
                }
                if (A.need_ctx || p0 >= CTX) {
#pragma unroll
                    for (int x = 0; x < 4; ++x) *(GAS u32x2*)(Og + (rbase + j) * ldo + 16 * (4 * dg + x) + 4 * qq) = pack4(o[x]);
                }
                bf16x8 kwf[2];
#pragma unroll
                for (int kk = 0; kk < 2; ++kk) kwf[kk] = trfrag(lds + L_KWS + (32 * kk + 4 * qq + (li >> 2)) * LROW + (16 * wid + 4 * (li & 3)) * 2, 16 * LROW);
#pragma unroll
                for (int t = 0; t < NVT; ++t) { cacc[t] = cacc[t] * decay;
#pragma unroll
                    for (int kk = 0; kk < 2; ++kk) cacc[t] = MFMA16(kwf[kk], trfrag(lds + L_VS + (32 * kk + 4 * qq + (li >> 2)) * LROW + (16 * t + 4 * (li & 3)) * 2, 16 * LROW), cacc[t]); }
            }
            __syncthreads();
#pragma unroll
            for (int t = 0; t < NVT; ++t) *(LAS u32x2*)(lds + L_CS + (16 * t + li) * BROW + (16 * wid + 4 * qq) * 2) = pack4(cacc[t]);
        }
        __syncthreads();
    }
#undef LA_LOAD
}

constexpr int A_KROW = 144, A_VROW = 160, A_KT = 0, A_VT = 64 * A_KROW, A_QT = A_VT + 64 * A_VROW;
DI void attn_unit(LAS unsigned char* lds, const MixArgs& A, int bl, int kvh, int qb, int hp, bool ctxq) {
    const int tid = lv(threadIdx.x), wid = __builtin_amdgcn_readfirstlane(tid >> 6), lane = tid & 63, li = lane & 15, qq = lane >> 4;
    const int gq = hp * 2 + (wid >> 2), q32 = wid & 3, head = kvh * 4 + gq;
    const size_t row0 = (size_t)bl * PT;
    const size_t qrow0 = row0 + (ctxq ? 0 : CTX) + qb * 128 + q32 * 32;
    const GAS bf16_t* AQ = (const GAS bf16_t*)(A.ws + PO_AQ); const GAS bf16_t* AK = (const GAS bf16_t*)(A.ws + PO_AK); const GAS bf16_t* AV = (const GAS bf16_t*)(A.ws + PO_AV);
    GAS bf16_t* Og = (GAS bf16_t*)(A.ws + WS_YCAT) + 512 + head * 64;
    const LAS unsigned char* qt = lds + A_QT + wid * 32 * A_KROW;
    __syncthreads();
#pragma unroll
    for (int it = 0; it < 4; ++it) { const int idx = lane + it * 64, row = idx >> 3, sg = idx & 7;
        *(LAS u32x4*)(lds + A_QT + (wid * 32 + row) * A_KROW + sg * 16) = *(const GAS u32x4*)(AQ + (qrow0 + row) * 512 + head * 64 + sg * 8); }
    const float sink = A.sink[head] * 1.4426950408889634f;
    float mrun[2], lsum[2]; f32x4 o[4][2];
#pragma unroll
    for (int jt = 0; jt < 2; ++jt) { mrun[jt] = sink; lsum[jt] = qq == 0 ? 1.f : 0.f;
#pragma unroll
        for (int d = 0; d < 4; ++d) o[d][jt] = (f32x4){0.f, 0.f, 0.f, 0.f}; }
    u32x4 rk, rv;
#define AT_LOAD(T) do { const size_t kr_ = (T) < 6 ? row0 + CTX + (size_t)((qb - 1) * 128 + (T) * 64) : row0 + (size_t)((T) - 6) * 64; \
        rk = *(const GAS u32x4*)(AK + (kr_ + (tid >> 3)) * 128 + kvh * 64 + (tid & 7) * 8); rv = *(const GAS u32x4*)(AV + (kr_ + (tid >> 3)) * 128 + kvh * 64 + (tid & 7) * 8); } while (0)
    int tix = ctxq ? 6 : (qb >= 1 ? 0 : 2);
    AT_LOAD(tix);
#pragma unroll 1
    while (tix < 10) {
        int nx = tix + 1; if (nx == 4 && qb == SEQ / 128 - 1) nx = 6;
        const bool local = tix < 6; const int kbase = (qb - 1) * 128 + tix * 64;
        __syncthreads();
        *(LAS u32x4*)(lds + A_KT + (tid >> 3) * A_KROW + (tid & 7) * 16) = rk; *(LAS u32x4*)(lds + A_VT + (tid >> 3) * A_VROW + (tid & 7) * 16) = rv;
        if (nx < 10) AT_LOAD(nx);
        __syncthreads();
        const int dq = local ? (qb * 128 + q32 * 32 - kbase) : 0; const bool partial = dq < -64 || dq > 96;
        if (dq < 192 && dq > -160) {
            bf16x8 kfr[4][2], vfr[4][2];
#pragma unroll
            for (int rt = 0; rt < 4; ++rt)
#pragma unroll
                for (int ks = 0; ks < 2; ++ks) kfr[rt][ks] = ldfrag(lds + A_KT + (16 * rt + li) * A_KROW + (32 * ks + 8 * qq) * 2);
#pragma unroll
            for (int d = 0; d < 4; ++d)
#pragma unroll
                for (int kk = 0; kk < 2; ++kk) vfr[d][kk] = trfrag(lds + A_VT + (32 * kk + 4 * qq + (li >> 2)) * A_VROW + (16 * d + 4 * (li & 3)) * 2, 16 * A_VROW);
#pragma unroll
            for (int jt = 0; jt < 2; ++jt) {
                bf16x8 qfj[2];
#pragma unroll
                for (int ks = 0; ks < 2; ++ks) qfj[ks] = ldfrag(qt + (16 * jt + li) * A_KROW + (32 * ks + 8 * qq) * 2);
                f32x4 s[4];
#pragma unroll
                for (int rt = 0; rt < 4; ++rt) { s[rt] = (f32x4){0.f, 0.f, 0.f, 0.f};
#pragma unroll
                    for (int ks = 0; ks < 2; ++ks) s[rt] = MFMA16(kfr[rt][ks], qfj[ks], s[rt]); }
                if (partial) {
                    const int qi = qb * 128 + q32 * 32 + 16 * jt + li;
#pragma unroll
                    for (int rt = 0; rt < 4; ++rt)
#pragma unroll
                        for (int e = 0; e < 4; ++e) { const int kj = kbase + 16 * rt + 4 * qq + e; const int dd = qi - kj; if (dd > 128 || dd < -128) s[rt][e] = -1e30f; }
                }
                float tm = s[0][0];
#pragma unroll
                for (int rt = 0; rt < 4; ++rt)
#pragma unroll
                    for (int e = 0; e < 4; ++e) tm = fmaxf(tm, s[rt][e]);
                tm = fmaxf(tm, __shfl_xor(tm, 16)); tm = fmaxf(tm, __shfl_xor(tm, 32));
                const float mn = fmaxf(mrun[jt], tm), alpha = __builtin_amdgcn_exp2f(mrun[jt] - mn); mrun[jt] = mn;
                float ps = 0.f;
#pragma unroll
                for (int rt = 0; rt < 4; ++rt)
#pragma unroll
                    for (int e = 0; e < 4; ++e) { const float p = __builtin_amdgcn_exp2f(s[rt][e] - mn); s[rt][e] = p; ps += p; }
                lsum[jt] = lsum[jt] * alpha + ps;
                bf16x8 pf[2]; pf[0] = pack8(s[0], s[1]); pf[1] = pack8(s[2], s[3]);
#pragma unroll
                for (int d = 0; d < 4; ++d) { f32x4 acc = o[d][jt] * alpha;
#pragma unroll
                    for (int kk = 0; kk < 2; ++kk) acc = MFMA16(vfr[d][kk], pf[kk], acc);
                    o[d][jt] = acc; }
            }
        }
        tix = nx;
    }
#undef AT_LOAD
#pragma unroll
    for (int jt = 0; jt < 2; ++jt) {
        float l = lsum[jt]; l += __shfl_xor(l, 16); l += __shfl_xor(l, 32);
        const float inv = __builtin_amdgcn_rcpf(l);
#pragma unroll
        for (int d = 0; d < 4; ++d) *(GAS u32x2*)(Og + (qrow0 + 16 * jt + li) * 2048 + 16 * d + 4 * qq) = pack4(o[d][jt] * inv);
    }
    __syncthreads();
}

DI void mixer_phase(LAS unsigned char* lds, const MixArgs& A, unsigned* ctr, int sel = 7) {
    const int total = 1216 + (A.need_ctx ? 64 : 0);
    LAS int* slot = (LAS int*)(lds + LDS_BYTES - 16);
    bool first = true;
    for (;;) {
        __syncthreads();
        if (threadIdx.x == 0) *slot = first ? (int)blockIdx.x : (int)(gridDim.x + atomicAdd(ctr, 1u));
        __syncthreads();
        first = false;
        const int u = __builtin_amdgcn_readfirstlane(*slot);
        if (u >= total) break;
        if (u < 64) { if (sel & 1) linattn_unit<true>(lds, A, u >> 3, (u >> 1) & 3, 0, u & 1); }
        else if (u < 192) { const int r = u - 64, within = r & 15, pid = (r >> 4) * 8 + (within & 7), vs = within >> 3;
            if (sel & 2) linattn_unit<false>(lds, A, pid >> 3, (pid >> 1) & 3, vs, pid & 1); }
        else if (u < 1216) { const int v = u - 192; if (sel & 4) attn_unit(lds, A, v >> 7, (v >> 6) & 1, (v >> 1) & 31, v & 1, false); }
        else { const int v = u - 1216; if (sel & 4) attn_unit(lds, A, v >> 3, (v >> 2) & 1, (v >> 1) & 1, v & 1, true); }
    }
}
struct Params { const float* in[24]; float* out; unsigned char* ws; };
enum { I_X = 0, I_C, I_CTX, I_CCTX, I_MODW, I_MODB, I_N1W, I_N2W, I_WIN, I_MGB, I_MCW, I_MNW, I_SINK, I_RLOG, I_RNW, I_BRM, I_BRA, I_BRR, I_WOUT, I_UP, I_FCW, I_FCB, I_DN, I_FNW };

DI int map_in(int n) {
    if (n < 2048) return n;
    if (n < 2064) return -1;
    if (n < 2704) { const int off = n - 2064, blk = off >> 5, w = off & 31, i = w & 15, hi = w >> 4; return 2048 + blk * 32 + 8 * (i >> 2) + 4 * hi + (i & 3); }
    if (n < 2832) return n - 16;
    if (n < 3856) { const int off = n - 2832, head = off >> 7, dim = off & 127, g = (dim & 63) >> 4, idx = dim & 15, hi = dim >> 6; return 2816 + head * 128 + 32 * g + 8 * (idx >> 2) + 4 * hi + (idx & 3); }
    return n - 16;
}
DI int map_up(int n) { const int hb = n >= FFN, s = hb ? n - FFN : n; return (s >> 7) * 256 + hb * 128 + (s & 127); }
DI void transpose_item(const float* W, int K, int N, bf16_t* WT, int ldw, int koff, int mode, LAS float* scr, int item, int lane) {
    const int nblk = (N + 31) / 32, kb = item / nblk, nb = item - kb * nblk, k0 = 64 * kb, n0 = 32 * nb;
    const int nl = n0 + (lane & 31);
    float tv[32];
#pragma unroll
    for (int i = 0; i < 32; ++i) { const int kk = 2 * i + (lane >> 5); tv[i] = nl < N ? W[(size_t)(k0 + kk) * N + nl] : 0.f; }
#pragma unroll
    for (int i = 0; i < 32; ++i) { const int kk = 2 * i + (lane >> 5); scr[kk * 33 + (lane & 31)] = tv[i]; }
    asm volatile("s_waitcnt lgkmcnt(0)" ::: "memory");
    const int c = lane & 7;
#pragma unroll
    for (int j = 0; j < 4; ++j) { const int nn = (lane >> 3) + 8 * j, n = n0 + nn; const LAS float* s = scr + (8 * c) * 33 + nn;
        u32x4 o; o.x = cvt_pk_bf16(s[0 * 33], s[1 * 33]); o.y = cvt_pk_bf16(s[2 * 33], s[3 * 33]); o.z = cvt_pk_bf16(s[4 * 33], s[5 * 33]); o.w = cvt_pk_bf16(s[6 * 33], s[7 * 33]);
        const int dr = n < N ? (mode == 1 ? map_in(n) : (mode == 2 ? map_up(n) : n)) : -1;
        if (dr >= 0) *(GAS u32x4*)(WT + (size_t)dr * ldw + koff + k0 + 8 * c) = o; }
    asm volatile("s_waitcnt lgkmcnt(0)" ::: "memory");
}
DI float wave_sum(float v) {
#pragma unroll
    for (int o = 1; o < 64; o <<= 1) v += __shfl_xor(v, o);
    return v;
}
DI void p0_prologue(const Params& p, LAS unsigned char* lds) {
    const int tid = lv(threadIdx.x), wid = __builtin_amdgcn_readfirstlane(tid >> 6), lane = tid & 63, G = gridDim.x;
    {
        LAS float* scr = (LAS float*)(lds + wid * 8448);
        constexpr int I_IN = 16 * 281, I_BM = 8 * 32, I_BR = 16 * 32, I_O = 16 * 32, I_U = 16 * 176, I_D = 44 * 32, PER = I_IN + 2 * I_BM + I_BR + I_O + I_U + I_D;
        for (int it = blockIdx.x * 8 + wid; it < 2 * PER; it += G * 8) {
            const int l = it / PER; int r = it - l * PER; unsigned char* wb = p.ws + WS_W + (size_t)l * W_LAYER;
            if (r < I_IN) { transpose_item(p.in[I_WIN] + (size_t)l * D * IN_COLS, D, IN_COLS, (bf16_t*)(wb + WO_IN), 1024, 0, 1, scr, r, lane); continue; } r -= I_IN;
            if (r < I_BM) { transpose_item(p.in[I_BRM] + (size_t)l * 512 * D, 512, D, (bf16_t*)(wb + WO_BR), 2048, 0, 0, scr, r, lane); continue; } r -= I_BM;
            if (r < I_BM) { transpose_item(p.in[I_BRA] + (size_t)l * 512 * D, 512, D, (bf16_t*)(wb + WO_BR), 2048, 512, 0, scr, r, lane); continue; } r -= I_BM;
            if (r < I_BR) { transpose_item(p.in[I_BRR] + (size_t)l * D * D, D, D, (bf16_t*)(wb + WO_BR), 2048, 1024, 0, scr, r, lane); continue; } r -= I_BR;
            if (r < I_O) { transpose_item(p.in[I_WOUT] + (size_t)l * D * D, D, D, (bf16_t*)(wb + WO_OUT), 1024, 0, 0, scr, r, lane); continue; } r -= I_O;
            if (r < I_U) { transpose_item(p.in[I_UP] + (size_t)l * D * 2 * FFN, D, 2 * FFN, (bf16_t*)(wb + WO_UP), 1024, 0, 2, scr, r, lane); continue; } r -= I_U;
            transpose_item(p.in[I_DN] + (size_t)l * FFN * D, FFN, D, (bf16_t*)(wb + WO_DN), FFN, 0, 0, scr, r, lane);
        }
    }
    {
        LAS float* st = (LAS float*)lds; LAS float* red = (LAS float*)(lds + 69632);
        float* MOD = (float*)(p.ws + WS_MOD);
        for (int u = blockIdx.x; u < 192; u += G) {
            const int l = u / 96, n0 = (u - l * 96) * 64;
            __syncthreads();
            for (int i = tid; i < 17 * 1024; i += 512) { const int v = i >> 10, k = i & 1023; const float cv = v < 16 ? p.in[I_C][v * 1024 + k] : p.in[I_CCTX][k]; st[i] = cv / (1.f + expf(-cv)); }
            __syncthreads();
            const int col = tid & 63, kp = tid >> 6;
            float acc[17];
#pragma unroll
            for (int v = 0; v < 17; ++v) acc[v] = 0.f;
            const float* wp = p.in[I_MODW] + ((size_t)l * 1024 + kp * 128) * 6144 + n0 + col;
#pragma unroll 16
            for (int k = 0; k < 128; ++k) { const float w = wp[(size_t)k * 6144];
#pragma unroll
                for (int v = 0; v < 17; ++v) acc[v] += st[v * 1024 + kp * 128 + k] * w; }
#pragma unroll
            for (int v = 0; v < 17; ++v) red[(kp * 17 + v) * 64 + col] = acc[v];
            __syncthreads();
            for (int i = tid; i < 17 * 64; i += 512) { const int v = i >> 6, cc = i & 63; float s = 0.f;
#pragma unroll
                for (int q = 0; q < 8; ++q) s += red[(q * 17 + v) * 64 + cc];
                MOD[((size_t)l * 17 + v) * 6144 + n0 + cc] = s + p.in[I_MODB][l * 6144 + n0 + cc]; }
        }
        __syncthreads();
    }
    {
        float* tab = (float*)(p.ws + WS_TAB);
        for (int idx = blockIdx.x * 512 + tid; idx < PT * 64 + 1024; idx += G * 512) {
            int pos, ti; float inv;
            if (idx < PT * 64) { pos = idx >> 6; const int i = idx & 63; inv = exp2f(-(float)i * (13.287712379549449f / 64.f)); ti = idx; }
            else { const int k = idx - PT * 64; pos = k >> 4; const int i = k & 15; inv = exp2f(-(float)i * (13.287712379549449f / 16.f)); ti = k; }
            const double ang = (double)pos * (double)inv; const double rev = ang * 0.15915494309189535; const double fr = rev - __builtin_rint(rev);
            const float a = (float)(fr * 6.283185307179586);
            const float cs = __cosf(a), sn = __sinf(a);
            if (idx < PT * 64) { tab[TAB_COSR + ti] = cs; tab[TAB_SINR + ti] = sn; } else { tab[TAB_COSA + ti] = cs; tab[TAB_SINA + ti] = sn; }
        }
    }
}

DI void norm_phase(const Params& p, LAS unsigned char* lds, int half, int l, int which, int first, int skip_ctx) {
    const int tid = lv(threadIdx.x), wid = __builtin_amdgcn_readfirstlane(tid >> 6), lane = tid & 63, G = gridDim.x;
    LAS float* wg = (LAS float*)lds;
    if (which == 0) {
        __syncthreads();
        const float* win = p.in[I_WIN] + (size_t)l * D * IN_COLS;
        for (int i = tid; i < 16384; i += 512) { const int k = i >> 4, g = i & 15; wg[g * 1024 + k] = win[(size_t)k * IN_COLS + 2048 + g]; }
        __syncthreads();
    }
    const float* MOD = (const float*)(p.ws + WS_MOD);
    const float* nw = p.in[which ? I_N2W : I_N1W] + l * D;
    bf16_t* HN = (bf16_t*)(p.ws + WS_HN);
    float* MG = (float*)(p.ws + PO_MG);
    float* xc = (float*)(p.ws + WS_XC);
#define NP_SRC(R, PTR) do { const int bl_ = (R) / PT, pp_ = (R) - bl_ * PT, b_ = half * HB + bl_; const bool c_ = pp_ < CTX; \
        const size_t ro_ = c_ ? ((size_t)b_ * CTX + pp_) * D : ((size_t)b_ * SEQ + (pp_ - CTX)) * D; \
        PTR = first ? ((c_ ? p.in[I_CTX] : p.in[I_X]) + ro_) : ((c_ ? xc : p.out) + ro_); } while (0)
    f32x4 vn[4];
    { const int r0 = blockIdx.x * 8 + wid; if (r0 < MH) { const float* s0; NP_SRC(r0, s0);
#pragma unroll
        for (int j = 0; j < 4; ++j) vn[j] = *(const GAS f32x4*)(s0 + 4 * (lane + 64 * j)); } }
    for (int r = blockIdx.x * 8 + wid; r < MH; r += G * 8) {
        const int bl = r / PT, pp = r - bl * PT, b = half * HB + bl; const bool is_ctx = pp < CTX;
        f32x4 v[4];
#pragma unroll
        for (int j = 0; j < 4; ++j) v[j] = vn[j];
        { const int r2 = r + G * 8; if (r2 < MH) { const float* s2; NP_SRC(r2, s2);
#pragma unroll
            for (int j = 0; j < 4; ++j) vn[j] = *(const GAS f32x4*)(s2 + 4 * (lane + 64 * j)); } }
        if (is_ctx && skip_ctx) continue;
        const float* mod = MOD + ((size_t)l * 17 + (is_ctx ? 16 : b)) * 6144;
        const float* sh = mod + (which ? 3 : 0) * 1024; const float* sc = mod + (which ? 4 : 1) * 1024;
        float ss = 0.f;
#pragma unroll
        for (int j = 0; j < 4; ++j) ss += v[j][0] * v[j][0] + v[j][1] * v[j][1] + v[j][2] * v[j][2] + v[j][3] * v[j][3];
        const float rstd = rsqrtf(wave_sum(ss) * (1.f / D) + 1e-6f);
#pragma unroll
        for (int j = 0; j < 4; ++j) { const int c = 4 * (lane + 64 * j);
            const f32x4 w4 = *(const GAS f32x4*)(nw + c), s4 = *(const GAS f32x4*)(sc + c), h4 = *(const GAS f32x4*)(sh + c);
            v[j] = v[j] * rstd * w4 * (s4 + 1.f) + h4;
            *(GAS u32x2*)(HN + (size_t)r * D + c) = pack4(v[j]); }
        if (which == 0) {
            float part[16];
#pragma unroll
            for (int g = 0; g < 16; ++g) { float a = 0.f;
#pragma unroll
                for (int j = 0; j < 4; ++j) { const f32x4 w4 = *(const LAS f32x4*)(wg + g * 1024 + 4 * (lane + 64 * j)); a += v[j][0] * w4[0] + v[j][1] * w4[1] + v[j][2] * w4[2] + v[j][3] * w4[3]; }
                part[g] = a; }
            float p8[8], p4[4], p2[2], p1;
            { const bool hi = lane & 32;
#pragma unroll
                for (int j = 0; j < 8; ++j) { const float keep = hi ? part[j + 8] : part[j], send = hi ? part[j] : part[j + 8]; p8[j] = keep + __shfl_xor(send, 32); } }
            { const bool hi = lane & 16;
#pragma unroll
                for (int j = 0; j < 4; ++j) { const float keep = hi ? p8[j + 4] : p8[j], send = hi ? p8[j] : p8[j + 4]; p4[j] = keep + __shfl_xor(send, 16); } }
            { const bool hi = lane & 8;
#pragma unroll
                for (int j = 0; j < 2; ++j) { const float keep = hi ? p4[j + 2] : p4[j], send = hi ? p4[j] : p4[j + 2]; p2[j] = keep + __shfl_xor(send, 8); } }
            { const bool hi = lane & 4; const float keep = hi ? p2[1] : p2[0], send = hi ? p2[0] : p2[1]; p1 = keep + __shfl_xor(send, 4); }
            p1 += __shfl_xor(p1, 1); p1 += __shfl_xor(p1, 2);
            const int gidx = ((lane >> 5) & 1) * 8 + ((lane >> 4) & 1) * 4 + ((lane >> 3) & 1) * 2 + ((lane >> 2) & 1);
            if ((lane & 3) == 0) { float val = p1 + p.in[I_MGB][l * 16 + gidx]; if ((gidx >> 2) & 1) val = logsigmoidf_(val); MG[(size_t)r * 16 + gidx] = val; }
        }
    }
}

DI void postmix_phase(const Params& p, int l, int skip_ctx) {
    const int tid = lv(threadIdx.x), wid = __builtin_amdgcn_readfirstlane(tid >> 6), lane = tid & 63, G = gridDim.x;
    bf16_t* Y = (bf16_t*)(p.ws + WS_YCAT); const bf16_t* MO = (const bf16_t*)(p.ws + PO_MO); const bf16_t* RG = (const bf16_t*)(p.ws + PO_RG);
    const bf16_t* HMB = (const bf16_t*)(p.ws + WS_HMB); const bf16_t* HRB = (const bf16_t*)(p.ws + WS_HRB);
    const float* mnw = p.in[I_MNW] + l * 512; const float* rnw = p.in[I_RNW] + l * 1024;
    float wm[8], wr_[16];
#pragma unroll
    for (int h = 0; h < 2; ++h) { const f32x4 t = *(const GAS f32x4*)(mnw + 8 * lane + 4 * h);
#pragma unroll
        for (int e = 0; e < 4; ++e) wm[4 * h + e] = t[e]; }
#pragma unroll
    for (int h = 0; h < 4; ++h) { const f32x4 t = *(const GAS f32x4*)(rnw + 16 * lane + 4 * h);
#pragma unroll
        for (int e = 0; e < 4; ++e) wr_[4 * h + e] = t[e]; }
    for (int r = blockIdx.x * 8 + wid; r < MH; r += G * 8) {
        const int pp = r % PT; if (pp < CTX && skip_ctx) continue;
        bf16_t* ym = Y + (size_t)r * 2048 + 8 * lane; bf16_t* yr = Y + (size_t)r * 2048 + 1024 + 16 * lane;
        const bf16_t* gp = RG + (size_t)r * 1024 + 16 * lane; const bf16_t* bp = HRB + (size_t)r * 1024 + 16 * lane;
        const u32x4 mraw = *(const GAS u32x4*)ym, mrb = *(const GAS u32x4*)(HMB + (size_t)r * 512 + 8 * lane), mgt = *(const GAS u32x4*)(MO + (size_t)r * 512 + 8 * lane);
        u32x4 raw[2], rb[2], gt[2]; raw[0] = *(const GAS u32x4*)yr; raw[1] = *(const GAS u32x4*)(yr + 8); gt[0] = *(const GAS u32x4*)gp; gt[1] = *(const GAS u32x4*)(gp + 8); rb[0] = *(const GAS u32x4*)bp; rb[1] = *(const GAS u32x4*)(bp + 8);
        {
            float x[8]; float s = 0.f;
#pragma unroll
            for (int e = 0; e < 4; ++e) { x[2 * e] = bflo(mraw[e]) + bflo(mrb[e]); x[2 * e + 1] = bfhi(mraw[e]) + bfhi(mrb[e]); s += x[2 * e] + x[2 * e + 1]; }
            s = rsum16(s);
            const float mu = s * (1.f / 128.f); float q = 0.f;
#pragma unroll
            for (int e = 0; e < 8; ++e) { x[e] -= mu; q += x[e] * x[e]; }
            q = rsum16(q);
            const float rs = rsqrtf(q * (1.f / 128.f) + 1e-6f);
            u32x4 o;
#pragma unroll
            for (int e = 0; e < 4; ++e) { const float a = x[2 * e] * rs * wm[2 * e] * bflo(mgt[e]), b2 = x[2 * e + 1] * rs * wm[2 * e + 1] * bfhi(mgt[e]); o[e] = cvt_pk_bf16(a, b2); }
            *(GAS u32x4*)ym = o;
        }
        {
            float x[16]; float s = 0.f;
#pragma unroll
            for (int e = 0; e < 8; ++e) { x[2 * e] = bflo(raw[e >> 2][e & 3]) + bflo(rb[e >> 2][e & 3]); x[2 * e + 1] = bfhi(raw[e >> 2][e & 3]) + bfhi(rb[e >> 2][e & 3]); s += x[2 * e] + x[2 * e + 1]; }
            s = rsum16(s);
            const float mu = s * (1.f / 256.f); float q = 0.f;
#pragma unroll
            for (int e = 0; e < 16; ++e) { x[e] -= mu; q += x[e] * x[e]; }
            q = rsum16(q);
            const float rs = rsqrtf(q * (1.f / 256.f) + 1e-6f);
            u32x4 o[2];
#pragma unroll
            for (int e = 0; e < 8; ++e) { const float a = x[2 * e] * rs * wr_[2 * e] * bflo(gt[e >> 2][e & 3]), b2 = x[2 * e + 1] * rs * wr_[2 * e + 1] * bfhi(gt[e >> 2][e & 3]); o[e >> 2][e & 3] = cvt_pk_bf16(a, b2); }
            *(GAS u32x4*)yr = o[0]; *(GAS u32x4*)(yr + 8) = o[1];
        }
    }
}

DI void edge_phase(const Params& p, int l, int skip_ctx) {
    const int tid = lv(threadIdx.x), G = gridDim.x;
    const bf16_t* SA = (const bf16_t*)(p.ws + WS_SA); const bf16_t* SB = (const bf16_t*)(p.ws + WS_SB); bf16_t* U = (bf16_t*)(p.ws + WS_FB);
    constexpr int NCG = FFN / 8, NT = (MH / 64) * 2 * NCG;
    for (int t = blockIdx.x * 512 + tid; t < NT; t += G * 512) {
        const int cg = t % NCG, bw = t / NCG, which = bw & 1, blk = bw >> 1, c0 = cg * 8;
        const int r = blk * 64 + (which ? 63 : 0), pp = r % PT;
        if (pp < CTX && skip_ctx) continue;
        const u32x4 z = (u32x4){0u, 0u, 0u, 0u};
        u32x4 ap, ac, an, bb;
        if (!which) { const bool pv = !(pp == 0 || pp == CTX);
            ap = pv ? *(const GAS u32x4*)(SA + ((size_t)(blk - 1) * 4 + 3) * FFN + c0) : z; ac = *(const GAS u32x4*)(SA + ((size_t)blk * 4 + 0) * FFN + c0); an = *(const GAS u32x4*)(SA + ((size_t)blk * 4 + 1) * FFN + c0);
            bb = *(const GAS u32x4*)(SB + ((size_t)blk * 2 + 0) * FFN + c0);
        } else { const bool nv = !(pp + 1 == CTX || pp + 1 == PT);
            ap = *(const GAS u32x4*)(SA + ((size_t)blk * 4 + 2) * FFN + c0); ac = *(const GAS u32x4*)(SA + ((size_t)blk * 4 + 3) * FFN + c0); an = nv ? *(const GAS u32x4*)(SA + ((size_t)(blk + 1) * 4 + 0) * FFN + c0) : z;
            bb = *(const GAS u32x4*)(SB + ((size_t)blk * 2 + 1) * FFN + c0);
        }
        float w0[8], w1[8], w2[8], bs[8];
#pragma unroll
        for (int h = 0; h < 2; ++h) {
            const f32x4 x0 = *(const GAS f32x4*)(p.in[I_FCW] + (l * 3 + 0) * FFN + c0 + 4 * h), x1 = *(const GAS f32x4*)(p.in[I_FCW] + (l * 3 + 1) * FFN + c0 + 4 * h);
            const f32x4 x2 = *(const GAS f32x4*)(p.in[I_FCW] + (l * 3 + 2) * FFN + c0 + 4 * h), xb = *(const GAS f32x4*)(p.in[I_FCB] + l * FFN + c0 + 4 * h);
#pragma unroll
            for (int e = 0; e < 4; ++e) { w0[4 * h + e] = x0[e]; w1[4 * h + e] = x1[e]; w2[4 * h + e] = x2[e]; bs[4 * h + e] = xb[e]; }
        }
        u32x4 o;
#pragma unroll
        for (int e = 0; e < 4; ++e) {
            const float t0 = w0[2 * e] * bflo(ap[e]) + w1[2 * e] * bflo(ac[e]) + w2[2 * e] * bflo(an[e]) + bs[2 * e];
            const float t1 = w0[2 * e + 1] * bfhi(ap[e]) + w1[2 * e + 1] * bfhi(ac[e]) + w2[2 * e + 1] * bfhi(an[e]) + bs[2 * e + 1];
            o[e] = cvt_pk_bf16(siluf_(t0) * bflo(bb[e]), siluf_(t1) * bfhi(bb[e]));
        }
        *(GAS u32x4*)(U + (size_t)r * FFN + c0) = o;
    }
}

DI void qk_edge_phase(const Params& p, int l) {
    const int tid = lv(threadIdx.x), G = gridDim.x;
    const bf16_t* SQ = (const bf16_t*)(p.ws + WS_SQ);
    constexpr int NCG = 128, NT = (MH / 64) * 2 * NCG;
    for (int t = blockIdx.x * 512 + tid; t < NT; t += G * 512) {
        const int cg = t % NCG, bw = t / NCG, wh = bw & 1, blk = bw >> 1, c0 = cg * 8, which = cg >> 6;
        const int r = blk * 64 + (wh ? 63 : 0), pp = r % PT;
        const u32x4 z = (u32x4){0u, 0u, 0u, 0u};
        u32x4 ap, ac, an;
        if (!wh) { const bool pv = !(pp == 0 || pp == CTX);
            ap = pv ? *(const GAS u32x4*)(SQ + ((size_t)(blk - 1) * 4 + 3) * 1024 + c0) : z; ac = *(const GAS u32x4*)(SQ + ((size_t)blk * 4 + 0) * 1024 + c0); an = *(const GAS u32x4*)(SQ + ((size_t)blk * 4 + 1) * 1024 + c0);
        } else { const bool nv = !(pp + 1 == CTX || pp + 1 == PT);
            ap = *(const GAS u32x4*)(SQ + ((size_t)blk * 4 + 2) * 1024 + c0); ac = *(const GAS u32x4*)(SQ + ((size_t)blk * 4 + 3) * 1024 + c0); an = nv ? *(const GAS u32x4*)(SQ + ((size_t)(blk + 1) * 4 + 0) * 1024 + c0) : z;
        }
        const float* cw = p.in[I_MCW] + l * 3 * 1024 + c0;
        float w0[8], w1[8], w2[8];
#pragma unroll
        for (int h = 0; h < 2; ++h) { const f32x4 x0 = *(const GAS f32x4*)(cw + 4 * h), x1 = *(const GAS f32x4*)(cw + 1024 + 4 * h), x2 = *(const GAS f32x4*)(cw + 2048 + 4 * h);
#pragma unroll
            for (int e = 0; e < 4; ++e) { w0[4 * h + e] = x0[e]; w1[4 * h + e] = x1[e]; w2[4 * h + e] = x2[e]; } }
        const float sc = which ? 0.08838834764831845f : 1.f;
        u32x4 o;
#pragma unroll
        for (int e = 0; e < 4; ++e) {
            const float t0 = w0[2 * e] * bflo(ap[e]) + w1[2 * e] * bflo(ac[e]) + w2[2 * e] * bflo(an[e]);
            const float t1 = w0[2 * e + 1] * bfhi(ap[e]) + w1[2 * e + 1] * bfhi(ac[e]) + w2[2 * e + 1] * bfhi(an[e]);
            o[e] = cvt_pk_bf16(siluf_(t0) * sc, siluf_(t1) * sc);
        }
        bf16_t* dst = (bf16_t*)(p.ws + (which ? PO_MKC : PO_MQC));
        *(GAS u32x4*)(dst + (size_t)r * 512 + (c0 & 511)) = o;
    }
}

DI void final_norm_phase(const Params& p, int half) {
    const int tid = lv(threadIdx.x), wid = __builtin_amdgcn_readfirstlane(tid >> 6), lane = tid & 63, G = gridDim.x;
    const float* fw = p.in[I_FNW];
    f32x4 vn[4];
    { const int r0 = blockIdx.x * 8 + wid; if (r0 < HB * SEQ) { const float* s0 = p.out + ((size_t)half * HB * SEQ + r0) * D;
#pragma unroll
        for (int j = 0; j < 4; ++j) vn[j] = *(const GAS f32x4*)(s0 + 4 * (lane + 64 * j)); } }
    for (int r = blockIdx.x * 8 + wid; r < HB * SEQ; r += G * 8) {
        float* xr = p.out + ((size_t)half * HB * SEQ + r) * D;
        f32x4 v[4]; float ss = 0.f;
#pragma unroll
        for (int j = 0; j < 4; ++j) { v[j] = vn[j]; ss += v[j][0] * v[j][0] + v[j][1] * v[j][1] + v[j][2] * v[j][2] + v[j][3] * v[j][3]; }
        { const int r2 = r + G * 8; if (r2 < HB * SEQ) { const float* s2 = p.out + ((size_t)half * HB * SEQ + r2) * D;
#pragma unroll
            for (int j = 0; j < 4; ++j) vn[j] = *(const GAS f32x4*)(s2 + 4 * (lane + 64 * j)); } }
        const float rstd = rsqrtf(wave_sum(ss) * (1.f / D) + 1e-6f);
#pragma unroll
        for (int j = 0; j < 4; ++j) { const f32x4 w4 = *(const GAS f32x4*)(fw + 4 * (lane + 64 * j)); *(GAS f32x4*)(xr + 4 * (lane + 64 * j)) = v[j] * rstd * w4; }
    }
}

#define XB_TMO      128
#define XB_XCNT(j)  (256  + 64 * (j))
#define XB_XSUB(j)  (1280 + 64 * (j))
#define XB_XGEN(j)  (2304 + 64 * (j))
#define XB_TOP      3328
#define XB_TOPGEN   3392
#define XCD_BAR_WORDS 3456
#define XB_SPIN_CAP (1u << 18)

__device__ __forceinline__ unsigned xb_ld(unsigned* p)              { return __hip_atomic_load(p, __ATOMIC_RELAXED, __HIP_MEMORY_SCOPE_AGENT); }
__device__ __forceinline__ unsigned xb_add(unsigned* p, unsigned v) { return __hip_atomic_fetch_add(p, v, __ATOMIC_RELAXED, __HIP_MEMORY_SCOPE_AGENT); }
__device__ __forceinline__ unsigned xb_xcc_id() { return (unsigned)__builtin_amdgcn_s_getreg((3 << 11) | 20) & 0xFu; }
#define XB_SPIN(cond, bar) do { unsigned _sp = 0; while (cond) { __builtin_amdgcn_s_sleep(1); \
    if ((++_sp & 255u) == 0u) { if (xb_ld(&(bar)[XB_TMO])) break; if (_sp > XB_SPIN_CAP) { atomicAdd(&(bar)[XB_TMO], 1u); break; } } } } while (0)

struct XcdBarrier {
    unsigned* bar; unsigned x;
    volatile LAS unsigned* st;
};

__device__ __forceinline__ XcdBarrier xcd_barrier_post(unsigned* bar, volatile LAS unsigned* st) {
    XcdBarrier b; b.bar = bar; b.x = xb_xcc_id(); b.st = st;
    if (threadIdx.x == 0) (void)xb_add(&bar[XB_XCNT(b.x)], 1u);
    return b;
}
__device__ __forceinline__ void xcd_barrier_complete(unsigned* bar, unsigned x, unsigned& nloc, unsigned& nx) {
    const unsigned G = gridDim.x * gridDim.y * gridDim.z;
    unsigned sum, cnt, mine, sp = 0u;
    for (;;) {
        sum = 0u; cnt = 0u; mine = 0u;
#pragma unroll
        for (unsigned j = 0; j < 16; ++j) { const unsigned c = xb_ld(&bar[XB_XCNT(j)]); sum += c; cnt += (c > 0u) ? 1u : 0u; mine = (j == x) ? c : mine; }
        if (sum == G) break;
        __builtin_amdgcn_s_sleep(1);
        if ((++sp & 255u) == 0u) { if (xb_ld(&bar[XB_TMO])) break; if (sp > XB_SPIN_CAP) { atomicAdd(&bar[XB_TMO], 1u); break; } }
    }
    nloc = mine > 0u ? mine : 1u; nx = cnt > 0u ? cnt : 1u;
}

__device__ __forceinline__ void xcd_barrier(const XcdBarrier& b) {
    asm volatile("s_waitcnt vmcnt(0)" ::: "memory");
    __syncthreads();
    if (threadIdx.x == 0) {
        unsigned* bar = b.bar;
        __builtin_amdgcn_s_waitcnt(0);
        unsigned nloc = b.st[0], nx = b.st[1];
        if (nloc == 0u) { xcd_barrier_complete(bar, b.x, nloc, nx); b.st[0] = nloc; b.st[1] = nx; }
        const unsigned old = xb_add(&bar[XB_XSUB(b.x)], 1u);
        const unsigned gen = old / nloc;
        if (old + 1u == (gen + 1u) * nloc) {
            __builtin_amdgcn_fence(__ATOMIC_RELEASE, "agent");
            asm volatile("s_waitcnt vmcnt(0)" ::: "memory");
            const unsigned og = xb_add(&bar[XB_TOP], 1u);
            const unsigned tg = og / nx;
            if (og + 1u == (tg + 1u) * nx) xb_add(&bar[XB_TOPGEN], 1u);
            else XB_SPIN(xb_ld(&bar[XB_TOPGEN]) == tg, bar);
            __builtin_amdgcn_fence(__ATOMIC_ACQUIRE, "agent");
            xb_add(&bar[XB_XGEN(b.x)], 1u);
            asm volatile("s_waitcnt vmcnt(0)" ::: "memory");
        } else {
            XB_SPIN(xb_ld(&bar[XB_XGEN(b.x)]) == gen, bar);
            __builtin_amdgcn_fence(__ATOMIC_ACQUIRE, "agent");
            asm volatile("s_waitcnt vmcnt(0)" ::: "memory");
        }
    }
    __syncthreads();
}


constexpr int CW_BAR = 4096;
__global__ void __launch_bounds__(512, 2) mk_fwd(Params p) {
    extern __shared__ __attribute__((aligned(16))) unsigned char lds_raw[];
    LAS unsigned char* lds = (LAS unsigned char*)lds_raw;
    cg::grid_group grid = cg::this_grid();
    volatile LAS unsigned* bst = (volatile LAS unsigned*)(lds + LDS_BYTES - 32);
    if (threadIdx.x == 0) { bst[0] = 0u; bst[1] = 0u; }
    __syncthreads();
    const XcdBarrier xbar = xcd_barrier_post((unsigned*)(p.ws + WS_CTL) + CW_BAR, bst);
    const int G = gridDim.x, bx = blockIdx.x;
#define RELOAD_WS() do { asm volatile("" : "+s"(p.ws)); p.ws = (unsigned char*)(GAS unsigned char*)p.ws; ws = p.ws; } while (0)
    unsigned char* ws = p.ws;
    PH(0) p0_prologue(p, lds);
    if (p.out == nullptr) grid.sync();
    xcd_barrier(xbar); RELOAD_WS();
    for (int half = 0; half < 2; ++half) {
        for (int l = 0; l < 2; ++l) {
            const int last = (l == 1), first = (l == 0);
#define wb (ws + WS_W + (size_t)l * W_LAYER)
#define MODl ((const float*)(ws + WS_MOD) + (size_t)l * 17 * 6144)
            PH(1) for (int rep = 0; rep < NREP(1); ++rep) norm_phase(p, lds, half, l, 0, first, 0);
            xcd_barrier(xbar); RELOAD_WS();
            PH(2) for (int rep = 0; rep < NREP(2); ++rep) {
                EpiIn E{ws, (const float*)(ws + WS_TAB), p.in[I_MCW] + l * 3 * 1024};
                if (!last) {
                    pg8::Sched1 S; S.o.init(MH, N_IN, G, bx); S.A = (const char*)(ws + WS_HN); S.B = (const char*)(wb + WO_IN); S.tsA = (size_t)256 * 1024 * 2; S.tsB = (size_t)256 * 1024 * 2; S.nt = 16;
                    pg8::gemm_phase(lds, 1024, 1024, S, E);
                } else {
                    pg8::SchedInLast S; S.o.init(MH, N_IN, G, bx, 1); S.A = (const char*)(ws + WS_HN); S.B = (const char*)(wb + WO_IN); S.tsA = (size_t)256 * 1024 * 2; S.tsB = (size_t)256 * 1024 * 2; S.nt = 16;
                    pg8::gemm_phase(lds, 1024, 1024, S, E);
                }
            }
            xcd_barrier(xbar); RELOAD_WS();
            qk_edge_phase(p, l);
            xcd_barrier(xbar); RELOAD_WS();
            PH(3) for (int rep = 0; rep < NREP(3); ++rep) {
                MixArgs A{ws, p.in[I_MCW] + l * 3 * 1024, p.in[I_SINK] + l * 8, p.in[I_RLOG] + l * 8, !last};
                mixer_phase(lds, A, (unsigned*)(ws + WS_CTL) + 64 * (half * 2 + l) + 256 * rep, rep ? PROBE_SEL : 7);
                if (rep + 1 < NREP(3)) xcd_barrier(xbar);
            }
            xcd_barrier(xbar); RELOAD_WS();
            PH(4) postmix_phase(p, l, last);
            xcd_barrier(xbar); RELOAD_WS();
            PH(5) for (int rep = 0; rep < NREP(5); ++rep) {
                pg8::Sched3 S; S.o.init(MH, 1024, G, bx, last); S.A = (const char*)(ws + WS_YCAT); S.B = (const char*)(wb + WO_BR); S.tsA = (size_t)256 * 2048 * 2; S.tsB = (size_t)256 * 2048 * 2;
                EpiBr E{(bf16_t*)(ws + WS_HN), (const bf16_t*)(ws + PO_G3)};
                pg8::gemm_phase(lds, 2048, 2048, S, E);
            }
            xcd_barrier(xbar); RELOAD_WS();
            PH(6) {
                pg8::Sched1 S; S.o.init(MH, 1024, G, bx, last); S.A = (const char*)(ws + WS_HN); S.B = (const char*)(wb + WO_OUT); S.tsA = (size_t)256 * 1024 * 2; S.tsB = (size_t)256 * 1024 * 2; S.nt = 16;
                EpiRes E{p.in[I_X], p.in[I_CTX], p.out, (float*)(ws + WS_XC), MODl + 2 * 1024, half, first, last};
                pg8::gemm_phase(lds, 1024, 1024, S, E);
            }
            xcd_barrier(xbar); RELOAD_WS();
            PH(7) for (int rep = 0; rep < NREP(7); ++rep) norm_phase(p, lds, half, l, 1, 0, last);
            xcd_barrier(xbar); RELOAD_WS();
            PH(8) for (int rep = 0; rep < NREP(8); ++rep) {
                pg8::Sched1 S; S.o.init(MH, 2 * FFN, G, bx, last); S.A = (const char*)(ws + WS_HN); S.B = (const char*)(wb + WO_UP); S.tsA = (size_t)256 * 1024 * 2; S.tsB = (size_t)256 * 1024 * 2; S.nt = 16;
                EpiUp E{(bf16_t*)(ws + WS_FB), (bf16_t*)(ws + WS_SA), (bf16_t*)(ws + WS_SB), p.in[I_FCW] + l * 3 * FFN, p.in[I_FCB] + l * FFN};
                pg8::gemm_phase(lds, 1024, 1024, S, E);
            }
            xcd_barrier(xbar); RELOAD_WS();
            PH(9) edge_phase(p, l, last);
            xcd_barrier(xbar); RELOAD_WS();
            PH(10) {
                pg8::Sched1 S; S.o.init(MH, 1024, G, bx, last); S.A = (const char*)(ws + WS_FB); S.B = (const char*)(wb + WO_DN); S.tsA = (size_t)256 * FFN * 2; S.tsB = (size_t)256 * FFN * 2; S.nt = FFN / 64;
                EpiRes E{p.in[I_X], p.in[I_CTX], p.out, (float*)(ws + WS_XC), MODl + 5 * 1024, half, 0, last};
                pg8::gemm_phase(lds, FFN, FFN, S, E);
            }
            xcd_barrier(xbar); RELOAD_WS();
        }
        PH(11) final_norm_phase(p, half);
    }
}

extern "C" void kernel_launch(void* const* d_in, const int* in_sizes, int n_in, void* d_out, int out_size, void* d_ws, size_t ws_size, hipStream_t stream) {
    static int grid = 0;
    if (grid == 0) {
        int dev = 0, cus = 0, per_cu = 0;
        (void)hipGetDevice(&dev);
        (void)hipDeviceGetAttribute(&cus, hipDeviceAttributeMultiprocessorCount, dev);
        (void)hipFuncSetAttribute((const void*)mk_fwd, hipFuncAttributeMaxDynamicSharedMemorySize, LDS_BYTES);
        (void)hipOccupancyMaxActiveBlocksPerMultiprocessor(&per_cu, (const void*)mk_fwd, 512, LDS_BYTES);
        if (per_cu < 1) per_cu = 1;
        grid = cus * per_cu;
        if (ws_size < WS_SQ + 5 * MiB) { fprintf(stderr, "kernel_launch: workspace too small (%zu < %zu)\n", ws_size, (size_t)PO_END); grid = -1; }
    }
    if (grid < 0) return;
    (void)hipMemsetAsync((char*)d_ws + WS_CTL, 0, 65536, stream);
    Params p{};
    for (int i = 0; i < 24; ++i) p.in[i] = (const float*)d_in[i];
    p.out = (float*)d_out; p.ws = (unsigned char*)d_ws;
    void* args[] = {&p};
    hipError_t e = hipLaunchCooperativeKernel((void*)mk_fwd, dim3(grid), dim3(512), args, LDS_BYTES, stream);
    if (e != hipSuccess) fprintf(stderr, "cooperative launch failed: %s (grid %d)\n", hipGetErrorString(e), grid);
}
```
